# Optimizing an MI355X kernel written in HIP

```python
import math
import jax
import jax.numpy as jnp
from jax import lax
import numpy as np

D_MODEL = 1024
BATCH = 8
SEQ = 4096
DEPTH = 2

CHUNK = 64
MEM_TOKENS = 256
HEAD_DIM = 64
D_MEM = D_MODEL // 4
N_MEM_HEADS = 4
MEM_HEAD_DIM = D_MEM // N_MEM_HEADS
D_TOK = D_MODEL - D_MEM
S5_GROUP = 16
S5_GROUPS = D_TOK // S5_GROUP
S5_STATE = 64
N_FOX_HEADS = D_TOK // HEAD_DIM
Q_BLOCK = 128
D_FF = ((8 * D_MODEL // 3 + 127) // 128) * 128
CONV_W = 3
N_A_LAYERS = DEPTH // 2
N_B_LAYERS = DEPTH - N_A_LAYERS
EPS = 1e-6

kernel_name = "hybrid_s5_fox_yoco_encoder"


def rmsnorm(x, g):
    xf = x.astype(jnp.float32)
    y = xf * lax.rsqrt(jnp.mean(xf * xf, axis=-1, keepdims=True) + EPS)
    return (y * g.astype(jnp.float32)).astype(x.dtype)


def s5_mixer(u, a_re, a_im, log_dt, b_re, b_im, c_re, c_im, d_skip):
    f32 = jnp.float32
    bsz, seq, _ = u.shape
    n_chunks = seq // CHUNK
    uf = u.astype(f32)
    u_c = uf.reshape(bsz, n_chunks, CHUNK, S5_GROUPS, S5_GROUP).transpose(1, 2, 0, 3, 4)
    dt = jnp.exp(log_dt.astype(f32))[:, None]
    lam_re = jnp.minimum(a_re.astype(f32), -1e-4)
    lam_im = a_im.astype(f32)
    mag = jnp.exp(lam_re * dt)
    ph = lam_im * dt
    ab_re, ab_im = mag * jnp.cos(ph), mag * jnp.sin(ph)
    den = lam_re * lam_re + lam_im * lam_im
    z_re = ((ab_re - 1.0) * lam_re + ab_im * lam_im) / den
    z_im = (ab_im * lam_re - (ab_re - 1.0) * lam_im) / den
    br, bi = b_re.astype(f32), b_im.astype(f32)
    bb_re = z_re[..., None] * br - z_im[..., None] * bi
    bb_im = z_re[..., None] * bi + z_im[..., None] * br
    steps = jnp.arange(1, CHUNK + 1, dtype=f32)[:, None, None]
    pw_mag = jnp.exp(lam_re * dt * steps)
    pw_ph = lam_im * dt * steps
    pw_re, pw_im = pw_mag * jnp.cos(pw_ph), pw_mag * jnp.sin(pw_ph)
    pw_re, pw_im = pw_re[:, None], pw_im[:, None]
    a_el_re = jnp.broadcast_to(ab_re, (CHUNK, bsz, S5_GROUPS, S5_STATE))
    a_el_im = jnp.broadcast_to(ab_im, (CHUNK, bsz, S5_GROUPS, S5_STATE))
    cr, ci = c_re.astype(f32), c_im.astype(f32)

    def combine(e1, e2):
        a1r, a1i, b1r, b1i = e1
        a2r, a2i, b2r, b2i = e2
        return (a2r * a1r - a2i * a1i, a2r * a1i + a2i * a1r,
                a2r * b1r - a2i * b1i + b2r, a2r * b1i + a2i * b1r + b2i)

    def chunk_step(carry, uc):
        hp_re, hp_im = carry
        bu_re = jnp.einsum('lbgi,gpi->lbgp', uc, bb_re)
        bu_im = jnp.einsum('lbgi,gpi->lbgp', uc, bb_im)
        _, _, h_re, h_im = lax.associative_scan(combine, (a_el_re, a_el_im, bu_re, bu_im), axis=0)
        h_re = h_re + pw_re * hp_re[None] - pw_im * hp_im[None]
        h_im = h_im + pw_re * hp_im[None] + pw_im * hp_re[None]
        y = jnp.einsum('lbgp,gip->lbgi', h_re, cr) - jnp.einsum('lbgp,gip->lbgi', h_im, ci)
        return (h_re[-1], h_im[-1]), y

    h0 = jnp.zeros((bsz, S5_GROUPS, S5_STATE), f32)
    _, y = lax.scan(chunk_step, (h0, h0), u_c)
    y = y.transpose(2, 0, 1, 3, 4).reshape(bsz, seq, D_TOK) + d_skip.astype(f32) * uf
    return y.astype(u.dtype)


def memory_attention(q, mem_n, w_mem_kv):
    bsz, seq, _ = q.shape
    kv = mem_n @ w_mem_kv
    k, v = jnp.split(kv, 2, axis=-1)
    k = k.reshape(bsz, MEM_TOKENS, N_MEM_HEADS, MEM_HEAD_DIM)
    v = v.reshape(bsz, MEM_TOKENS, N_MEM_HEADS, MEM_HEAD_DIM)
    qh = q.reshape(bsz, seq, N_MEM_HEADS, MEM_HEAD_DIM)
    s = jnp.einsum('bshd,bmhd->bhsm', qh, k).astype(jnp.float32) * (MEM_HEAD_DIM ** -0.5)
    p = jax.nn.softmax(s, axis=-1)
    o = jnp.einsum('bhsm,bmhd->bshd', p.astype(v.dtype), v)
    return o.reshape(bsz, seq, D_MEM)


def forgetting_attention(q, k, v, fcum):
    bsz, seq, _, _ = q.shape
    scale = HEAD_DIM ** -0.5
    outs = []
    for i in range(seq // Q_BLOCK):
        q0, q1 = i * Q_BLOCK, (i + 1) * Q_BLOCK
        qs = q[:, q0:q1]
        s = jnp.einsum('bqhd,bkhd->bhqk', qs, k[:, :q1]).astype(jnp.float32) * scale
        s = s + fcum[:, :, q0:q1, None] - fcum[:, :, None, :q1]
        qpos = q0 + jnp.arange(Q_BLOCK)
        kpos = jnp.arange(q1)
        s = jnp.where(qpos[:, None] >= kpos[None, :], s, -jnp.inf)
        p = jax.nn.softmax(s, axis=-1)
        outs.append(jnp.einsum('bhqk,bkhd->bqhd', p.astype(v.dtype), v[:, :q1]))
    return jnp.concatenate(outs, axis=1).reshape(bsz, seq, D_TOK)


def conv_ffn(x, w_up, conv_w, conv_b, w_down):
    seq = x.shape[1]
    up = x @ w_up
    a, g = jnp.split(up, 2, axis=-1)
    gp = jnp.pad(g, ((0, 0), (CONV_W - 1, 0), (0, 0)))
    gc = gp[:, 0:seq] * conv_w[0] + gp[:, 1:seq + 1] * conv_w[1] + gp[:, 2:seq + 2] * conv_w[2] + conv_b
    return (jax.nn.silu(gc) * a) @ w_down


def setup_inputs(seed: int = 0) -> dict:
    key = jax.random.key(seed)
    ks = jax.random.split(key, 32)
    f32 = jnp.float32
    nrm = lambda k, shape, s: jax.random.normal(k, shape, f32) * s
    n_idx = jnp.arange(S5_STATE, dtype=f32)
    return {
        "x": nrm(ks[0], (BATCH, SEQ, D_MODEL), 1.0),
        "mem": nrm(ks[1], (BATCH, MEM_TOKENS, D_MODEL), 1.0),
        "g_mix": 1.0 + nrm(ks[2], (DEPTH, D_MODEL), 0.02),
        "w_in": nrm(ks[3], (DEPTH, D_MODEL, D_MODEL), D_MODEL ** -0.5),
        "w_out": nrm(ks[4], (DEPTH, D_MODEL, D_MODEL), D_MODEL ** -0.5),
        "g_mem": 1.0 + nrm(ks[5], (D_MODEL,), 0.02),
        "w_mem_kv": nrm(ks[6], (DEPTH, D_MODEL, 2 * D_MEM), D_MODEL ** -0.5),
        "s5_a_re": -0.5 + nrm(ks[7], (N_A_LAYERS, S5_GROUPS, S5_STATE), 0.01),
        "s5_a_im": math.pi * n_idx + nrm(ks[8], (N_A_LAYERS, S5_GROUPS, S5_STATE), 0.01),
        "s5_log_dt": jax.random.uniform(ks[9], (N_A_LAYERS, S5_GROUPS), f32, math.log(1e-3), math.log(1e-1)),
        "s5_b_re": nrm(ks[10], (N_A_LAYERS, S5_GROUPS, S5_STATE, S5_GROUP), (2 * S5_GROUP) ** -0.5),
        "s5_b_im": nrm(ks[11], (N_A_LAYERS, S5_GROUPS, S5_STATE, S5_GROUP), (2 * S5_GROUP) ** -0.5),
        "s5_c_re": nrm(ks[12], (N_A_LAYERS, S5_GROUPS, S5_GROUP, S5_STATE), S5_STATE ** -0.5),
        "s5_c_im": nrm(ks[13], (N_A_LAYERS, S5_GROUPS, S5_GROUP, S5_STATE), S5_STATE ** -0.5),
        "s5_d": nrm(ks[14], (N_A_LAYERS, D_TOK), 1.0),
        "w_glu": nrm(ks[15], (N_A_LAYERS, D_TOK, D_TOK), D_TOK ** -0.5),
        "g_kv": 1.0 + nrm(ks[16], (D_MODEL,), 0.02),
        "w_kv": nrm(ks[17], (D_MODEL, 2 * D_TOK), D_MODEL ** -0.5),
        "w_fgate": nrm(ks[18], (D_MODEL, N_FOX_HEADS), 0.5 * D_MODEL ** -0.5),
        "b_fgate": jax.random.uniform(ks[19], (N_FOX_HEADS,), f32, 1.0, 6.0),
        "g_ffn": 1.0 + nrm(ks[20], (DEPTH, D_MODEL), 0.02),
        "w_ffn_up": nrm(ks[21], (DEPTH, D_MODEL, 2 * D_FF), D_MODEL ** -0.5),
        "conv_w": nrm(ks[22], (DEPTH, CONV_W, D_FF), CONV_W ** -0.5),
        "conv_b": nrm(ks[23], (DEPTH, D_FF), 0.02),
        "w_ffn_down": nrm(ks[24], (DEPTH, D_FF, D_MODEL), D_FF ** -0.5),
        "g_final": 1.0 + nrm(ks[25], (D_MODEL,), 0.02),
    }


def reference(x, mem, g_mix, w_in, w_out, g_mem, w_mem_kv, s5_a_re, s5_a_im, s5_log_dt,
              s5_b_re, s5_b_im, s5_c_re, s5_c_im, s5_d, w_glu, g_kv, w_kv, w_fgate, b_fgate,
              g_ffn, w_ffn_up, conv_w, conv_b, w_ffn_down, g_final):
    bsz, seq, _ = x.shape
    h = x
    mem_n = rmsnorm(mem, g_mem)
    k_sh = v_sh = fcum_sh = None
    for l in range(DEPTH):
        hn = rmsnorm(h, g_mix[l])
        proj = hn @ w_in[l]
        tok_in, q_mem = proj[..., :D_TOK], proj[..., D_TOK:]
        if l < N_A_LAYERS:
            y = s5_mixer(tok_in, s5_a_re[l], s5_a_im[l], s5_log_dt[l], s5_b_re[l], s5_b_im[l],
                         s5_c_re[l], s5_c_im[l], s5_d[l])
            g = jax.nn.gelu(y)
            tok_out = g * jax.nn.sigmoid(g @ w_glu[l])
        else:
            q = tok_in.reshape(bsz, seq, N_FOX_HEADS, HEAD_DIM)
            tok_out = forgetting_attention(q, k_sh, v_sh, fcum_sh)
        mem_out = memory_attention(q_mem, mem_n, w_mem_kv[l])
        h = h + jnp.concatenate([tok_out, mem_out], axis=-1) @ w_out[l]
        h = h + conv_ffn(rmsnorm(h, g_ffn[l]), w_ffn_up[l], conv_w[l], conv_b[l], w_ffn_down[l])
        if l == N_A_LAYERS - 1:
            hs = rmsnorm(h, g_kv)
            kv = hs @ w_kv
            k_sh = kv[..., :D_TOK].reshape(bsz, seq, N_FOX_HEADS, HEAD_DIM)
            v_sh = kv[..., D_TOK:].reshape(bsz, seq, N_FOX_HEADS, HEAD_DIM)
            logf = jax.nn.log_sigmoid((hs @ w_fgate + b_fgate).astype(jnp.float32))
            fcum_sh = jnp.cumsum(logf, axis=1).transpose(0, 2, 1)
    return rmsnorm(h, g_final)
```

```cpp
#include <hip/hip_runtime.h>
#include <hip/hip_cooperative_groups.h>
#include <hip/hip_bf16.h>
#include <cstdio>
#include <cstdint>
#include <cmath>
namespace cg = cooperative_groups;
namespace pg8 {
#define PG8_LAS __attribute__((address_space(3)))
typedef unsigned short bf16_t;
typedef short bf16x8 __attribute__((ext_vector_type(8)));
typedef float f32x4 __attribute__((ext_vector_type(4)));
typedef unsigned u32x4 __attribute__((ext_vector_type(4)));
constexpr int BM = 256, BK = 64, HALF = 128, HTB = HALF * BK * 2  , STAGE_BYTES = 8 * HTB, NXCD = 8, WGM = 4;

__host__ __device__ __forceinline__ int lds_byte(int r, int c) { const int st = (r >> 4) * 2 + (c >> 5), rr = r & 15, cc = c & 31, ob = rr * 64 + cc * 2; return st * 1024 + (ob ^ (((ob >> 9) & 1) << 5)); }
__host__ __device__ __forceinline__ void stage_rc(int b, int& R, int& C) { const int st = b / 1024, sb = b % 1024, swz = sb ^ (((sb >> 9) & 1) << 5); R = (st >> 1) * 16 + swz / 64; C = (st & 1) * 32 + (swz % 64) / 2; }
__host__ __device__ __forceinline__ int perm32(int rho) { const int n = rho >> 4, i = rho & 15; return 8 * (i >> 2) + 4 * n + (i & 3); }

struct Unit { int pm, pn; };
struct Gemm { const bf16_t* A; const bf16_t* Bt; int M, N, K, lda, ldb; };

struct StaticOrder {
    int nM, nN, nwg, G, c;
    __host__ __device__ __forceinline__ void init(int M, int N, int G_, int c_) { nM = M / BM; nN = N / BM; nwg = nM * nN; G = G_; c = c_; }
    __host__ __device__ __forceinline__ bool next(int i, Unit& u) const {
        const long L = (long)i * G + c; if (L >= nwg) return false;
        int wgid = (int)L; { const int q = nwg / NXCD, r = nwg % NXCD, xcd = wgid % NXCD, off = wgid / NXCD; wgid = (xcd < r ? xcd * (q + 1) : r * (q + 1) + (xcd - r) * q) + off; }
        const int nig = WGM * nN, gid = wgid / nig, fm = gid * WGM, gsz = (nM - fm) < WGM ? (nM - fm) : WGM;
        u.pm = fm + ((wgid % nig) % gsz); u.pn = (wgid % nig) / gsz; return true;
    }
    __device__ __forceinline__ void a_ready(const Unit&) const {}
    __device__ __forceinline__ void done(const Unit&) const {}
};

__device__ __forceinline__ unsigned cvt_pk_bf16(float lo, float hi) { unsigned r; asm volatile("v_cvt_pk_bf16_f32 %0, %1, %2" : "=v"(r) : "v"(lo), "v"(hi)); return r; }
template <class Epi, class Sched, bool ALIGN_EPI = false, bool SP2 = false, int AMODE = 0>
__device__ __forceinline__ void gemm_phase(PG8_LAS unsigned char* lds, const Gemm g, const Sched& S, const Epi& E) {
    int tid_o = threadIdx.x; asm volatile("" : "+v"(tid_o)); const int tid = tid_o, wid = __builtin_amdgcn_readfirstlane(tid >> 6), lane = tid & 63, wr = wid >> 2, wc = wid & 3, fr = lane & 15, fq = lane >> 4;
    const int K = g.K, nt = K / BK;
    unsigned voffA[2], voffB[2];
#pragma unroll
    for (int i = 0; i < 2; ++i) { int R, C; stage_rc(tid * 16 + i * 8192, R, C); const int Rb = Epi::PERM ? ((R & ~31) + perm32(R & 31)) : R;
        const int Ra = (AMODE == 1) ? ((R >> 6) * 128 + (R & 15) * 8 + ((R >> 4) & 3)) : R;
        voffA[i] = (unsigned)(Ra * g.lda + C) * 2u; voffB[i] = (unsigned)(Rb * g.ldb + C) * 2u; }
    const size_t kstep = (size_t)(BK * 2);
    const size_t hstepA = (AMODE == 1) ? (size_t)4 * g.lda * 2 : (size_t)HALF * g.lda * 2, hstepB = (size_t)HALF * g.ldb * 2;
    const size_t tstepA = (size_t)BM * g.lda * 2, tstepB = (size_t)BM * g.ldb * 2;
    const unsigned ldsw = (unsigned)wid * 1024u;
    const int aoff = lds_byte(wr * 64 + fr, fq * 8), boff = lds_byte(wc * 32 + fr, fq * 8);
#define PG8_SA(b, h) (((b) * 2 + (h)) * HTB)
#define PG8_SB(b, h) ((4 + (b) * 2 + (h)) * HTB)
#define PG8_STAGE(bufoff, gbase, voff) do { _Pragma("unroll") for (int _i = 0; _i < 2; ++_i) \
        __builtin_amdgcn_global_load_lds((const unsigned*)((const char*)(gbase) + (voff)[_i]), (PG8_LAS unsigned*)(lds + (bufoff) + ldsw + _i * 8192), 16, 0, 0); } while (0)
#define PG8_LDA(dst, b, h) do { _Pragma("unroll") for (int m = 0; m < 4; ++m) _Pragma("unroll") for (int k = 0; k < 2; ++k) dst[m][k] = *(const PG8_LAS bf16x8*)(lds + PG8_SA(b, h) + aoff + m * 2048 + k * 1024); } while (0)
#define PG8_LDB(dst, b, h) do { _Pragma("unroll") for (int n = 0; n < 2; ++n) _Pragma("unroll") for (int k = 0; k < 2; ++k) dst[n][k] = *(const PG8_LAS bf16x8*)(lds + PG8_SB(b, h) + boff + n * 2048 + k * 1024); } while (0)
#define PG8_MMA(ai, bj, At, Bt) do { __builtin_amdgcn_s_setprio(1); _Pragma("unroll") for (int m = 0; m < 4; ++m) _Pragma("unroll") for (int n = 0; n < 2; ++n) _Pragma("unroll") for (int k = 0; k < 2; ++k) \
        acc[ai][bj][m][n] = __builtin_amdgcn_mfma_f32_16x16x32_bf16(Bt[n][k], At[m][k], acc[ai][bj][m][n], 0, 0, 0); __builtin_amdgcn_s_setprio(0); } while (0)
#define PG8_WAIT_V(n) asm volatile("s_waitcnt vmcnt(" #n ")" ::: "memory")
#define PG8_WAIT_L(n) asm volatile("s_waitcnt lgkmcnt(" #n ")" ::: "memory")
#define PG8_BAR __builtin_amdgcn_s_barrier()
#define PG8_SCHED __builtin_amdgcn_sched_barrier(0)
    Unit cur, nxt; int ui = 0;
    if (!S.next(0, cur)) return;
    f32x4 acc[2][2][4][2];
#pragma unroll
    for (int a = 0; a < 2; ++a)
#pragma unroll
        for (int b = 0; b < 2; ++b)
#pragma unroll
            for (int m = 0; m < 4; ++m)
#pragma unroll
                for (int n = 0; n < 2; ++n) acc[a][b][m][n] = (f32x4){0.f, 0.f, 0.f, 0.f};
    bf16x8 At[4][2], B0[2][2], B1[2][2];
    const char* cA = (const char*)g.A + (size_t)cur.pm * tstepA; const char* cB = (const char*)g.Bt + (size_t)cur.pn * tstepB;
    S.a_ready(cur);
    if constexpr (SP2) {
        PG8_STAGE(PG8_SB(0, 0), cB, voffB); PG8_STAGE(PG8_SB(0, 1), cB + hstepB, voffB); PG8_STAGE(PG8_SA(0, 0), cA, voffA); PG8_STAGE(PG8_SA(0, 1), cA + hstepA, voffA);
        if (wr == 1) PG8_BAR;
        PG8_WAIT_V(2); PG8_BAR;
        PG8_STAGE(PG8_SB(1, 0), cB + kstep, voffB); PG8_STAGE(PG8_SA(1, 0), cA + kstep, voffA); PG8_STAGE(PG8_SB(1, 1), cB + hstepB + kstep, voffB);
        PG8_WAIT_V(6); PG8_BAR;
    } else {
        PG8_STAGE(PG8_SB(0, 0), cB, voffB); PG8_STAGE(PG8_SA(0, 0), cA, voffA); PG8_STAGE(PG8_SB(0, 1), cB + hstepB, voffB); PG8_STAGE(PG8_SA(0, 1), cA + hstepA, voffA);
        if (wr == 1) PG8_BAR;
        PG8_WAIT_V(4); PG8_BAR;
        PG8_STAGE(PG8_SB(1, 0), cB + kstep, voffB); PG8_STAGE(PG8_SA(1, 0), cA + kstep, voffA); PG8_STAGE(PG8_SB(1, 1), cB + hstepB + kstep, voffB);
        PG8_WAIT_V(6); PG8_BAR;
    }
    for (;;) {
        const bool has_next = S.next(ui + 1, nxt);
        const char* nA = has_next ? (const char*)g.A + (size_t)nxt.pm * tstepA : cA; const char* nB = has_next ? (const char*)g.Bt + (size_t)nxt.pn * tstepB : cB;
        for (int t = 0; t < nt; t += 2) {
            const bool last = (t == nt - 2);
            const char* a1 = cA + (size_t)(t + 1) * kstep;
            const char* a2 = last ? nA : cA + (size_t)(t + 2) * kstep; const char* b2 = last ? nB : cB + (size_t)(t + 2) * kstep;
            const char* a3 = a2 + kstep; const char* b3 = b2 + kstep;
            if (last && has_next) S.a_ready(nxt);
            if constexpr (SP2) {
            PG8_LDB(B0, 0, 0); PG8_LDB(B1, 0, 1); PG8_SCHED; PG8_LDA(At, 0, 0); PG8_STAGE(PG8_SA(1, 1), a1 + hstepA, voffA);
            PG8_WAIT_V(8); PG8_WAIT_L(0); PG8_BAR; PG8_MMA(0, 0, At, B0); PG8_MMA(0, 1, At, B1); PG8_BAR; PG8_SCHED;
            PG8_LDA(At, 0, 1); PG8_STAGE(PG8_SB(0, 0), b2, voffB); PG8_STAGE(PG8_SB(0, 1), b2 + hstepB, voffB); PG8_STAGE(PG8_SA(0, 0), a2, voffA);
            PG8_WAIT_V(8); PG8_WAIT_L(0); PG8_BAR; PG8_MMA(1, 0, At, B0); PG8_MMA(1, 1, At, B1); PG8_BAR; PG8_SCHED;
            PG8_LDB(B0, 1, 0); PG8_LDB(B1, 1, 1); PG8_SCHED; PG8_LDA(At, 1, 0); PG8_STAGE(PG8_SA(0, 1), a2 + hstepA, voffA);
            PG8_WAIT_V(8); PG8_WAIT_L(0); PG8_BAR; PG8_MMA(0, 0, At, B0); PG8_MMA(0, 1, At, B1); PG8_BAR; PG8_SCHED;
            PG8_LDA(At, 1, 1); PG8_STAGE(PG8_SB(1, 0), b3, voffB); PG8_STAGE(PG8_SB(1, 1), b3 + hstepB, voffB); PG8_STAGE(PG8_SA(1, 0), a3, voffA);
            PG8_WAIT_V(8); PG8_WAIT_L(0); PG8_BAR; PG8_MMA(1, 0, At, B0); PG8_MMA(1, 1, At, B1); PG8_BAR; PG8_SCHED;
            } else {
            PG8_LDB(B0, 0, 0); PG8_SCHED; PG8_LDA(At, 0, 0); PG8_STAGE(PG8_SA(1, 1), a1 + hstepA, voffA);
            PG8_WAIT_L(8); PG8_BAR; PG8_WAIT_L(0); PG8_MMA(0, 0, At, B0); PG8_BAR; PG8_SCHED;
            PG8_LDB(B1, 0, 1); PG8_STAGE(PG8_SB(0, 0), b2, voffB);
            PG8_BAR; PG8_WAIT_L(0); PG8_MMA(0, 1, At, B1); PG8_BAR;
            PG8_LDA(At, 0, 1); PG8_STAGE(PG8_SA(0, 0), a2, voffA);
            PG8_BAR; PG8_WAIT_L(0); PG8_MMA(1, 0, At, B0); PG8_BAR; PG8_SCHED;
            PG8_STAGE(PG8_SB(0, 1), b2 + hstepB, voffB);
            PG8_WAIT_V(6); PG8_BAR; PG8_MMA(1, 1, At, B1); PG8_BAR;
            PG8_LDB(B0, 1, 0); PG8_SCHED; PG8_LDA(At, 1, 0); PG8_STAGE(PG8_SA(0, 1), a2 + hstepA, voffA);
            PG8_WAIT_L(8); PG8_BAR; PG8_WAIT_L(0); PG8_MMA(0, 0, At, B0); PG8_BAR; PG8_SCHED;
            PG8_LDB(B1, 1, 1); PG8_STAGE(PG8_SB(1, 0), b3, voffB);
            PG8_BAR; PG8_WAIT_L(0); PG8_MMA(0, 1, At, B1); PG8_BAR;
            PG8_LDA(At, 1, 1); PG8_STAGE(PG8_SA(1, 0), a3, voffA);
            PG8_BAR; PG8_WAIT_L(0); PG8_MMA(1, 0, At, B0); PG8_BAR; PG8_SCHED;
            PG8_STAGE(PG8_SB(1, 1), b3 + hstepB, voffB);
            PG8_WAIT_V(6); PG8_BAR; PG8_MMA(1, 1, At, B1); PG8_BAR;
            }
        }
        if constexpr (ALIGN_EPI) { if (wr == 0) PG8_BAR; }
        if constexpr (!Epi::AFTER_DRAIN) { E(acc, cur, wr, wc, fr, fq); S.done(cur); }
        if (!has_next) break;
#pragma unroll
        for (int a = 0; a < 2; ++a)
#pragma unroll
            for (int b = 0; b < 2; ++b)
#pragma unroll
                for (int m = 0; m < 4; ++m)
#pragma unroll
                    for (int n = 0; n < 2; ++n) acc[a][b][m][n] = (f32x4){0.f, 0.f, 0.f, 0.f};
        cur = nxt; cA = nA; cB = nB; ++ui;
        if constexpr (ALIGN_EPI) { if (wr == 1) PG8_BAR; }
    }
    PG8_WAIT_V(0);
    if constexpr (!ALIGN_EPI) { if (wr == 0) PG8_BAR; }
    PG8_BAR;
    if constexpr (Epi::AFTER_DRAIN) { E.fused(acc, cur, wr, wc, fr, fq, lds, wid, lane); S.done(cur); }
#undef PG8_SA
#undef PG8_SB
#undef PG8_STAGE
#undef PG8_LDA
#undef PG8_LDB
#undef PG8_MMA
#undef PG8_WAIT_V
#undef PG8_WAIT_L
#undef PG8_BAR
#undef PG8_SCHED
}
}
#include <hip/hip_bf16.h>
namespace attn_body {
using bf16=__hip_bfloat16;
using bf16x8=__attribute__((ext_vector_type(8)))short;
using s16x4=__attribute__((ext_vector_type(4)))short;
using f32x16=__attribute__((ext_vector_type(16)))float;
using u32x4=__attribute__((ext_vector_type(4)))unsigned;
constexpr int D=64;
constexpr int NW=8,QBLK=32,QB=QBLK*NW,KVBLK=64;
constexpr int ATTN_UNIT_ROWS=QB; typedef float f32x4_t __attribute__((ext_vector_type(4))); typedef const __attribute__((address_space(3))) f32x4_t* lds_f4p;
__device__ __forceinline__ int crow(int r,int hi){return (r&3)+8*(r>>2)+4*hi;}
#define SBAR() __builtin_amdgcn_sched_barrier(0)
__device__ __forceinline__ void cmask(f32x16&p0,f32x16&p1,int jb,int qrel,int hi){
  const float NEG=-INFINITY; int kb=64*jb+4*hi;
  #pragma unroll
  for(int r=0;r<16;++r){int kv=kb+(r&3)+8*(r>>2); if(kv>qrel)p0[r]=NEG; if(kv+32>qrel)p1[r]=NEG;}
}

constexpr int NSLOT=3, SLOTB=8192;
constexpr int LDS_K=0, LDS_V=NSLOT*SLOTB, LDS_WS=2*NSLOT*SLOTB, LDS_OST=LDS_WS+NW*64*4, LDS_BYTES=LDS_OST+NW*4096;
constexpr float C2=0.125f*1.4426950408889634f;
__device__ __forceinline__ void glds16(const void*gsrc,unsigned lds_dst){unsigned keep;
  asm volatile("s_mov_b32 %0, m0\n\ts_mov_b32 m0, %2\n\ts_nop 0\n\tglobal_load_lds_dwordx4 %1, off\n\ts_mov_b32 m0, %0":"=&s"(keep):"v"(gsrc),"s"(lds_dst):"memory");}
__device__ __forceinline__ float max3f(float a,float b,float c){float r;asm("v_max3_f32 %0, %1, %2, %3":"=v"(r):"v"(a),"v"(b),"v"(c));return r;}
__device__ __forceinline__ float max2f(float a,float b){float r;asm("v_max_f32_e32 %0, %1, %2":"=v"(r):"v"(a),"v"(b));return r;}
__device__ __forceinline__ float fadd_s(float a,float b){float r;asm("v_add_f32_e32 %0, %1, %2":"=v"(r):"v"(a),"v"(b));return r;}
__device__ __forceinline__ float fsub_s(float a,float b){float r;asm("v_sub_f32_e32 %0, %1, %2":"=v"(r):"v"(a),"v"(b));return r;}
typedef float f32x2_t __attribute__((ext_vector_type(2))); typedef __bf16 bf16x2_t __attribute__((ext_vector_type(2)));
__device__ __forceinline__ unsigned cvtpk_s(float lo,float hi){f32x2_t v={lo,hi};bf16x2_t b=__builtin_convertvector(v,bf16x2_t);return __builtin_bit_cast(unsigned,b);}
#define WAIT_BAR(N) asm volatile("s_waitcnt vmcnt(" #N ") lgkmcnt(0)\n\ts_barrier":::"memory")

__device__ __forceinline__ void qkt(f32x16&p0,f32x16&p1,const char*Kslot,const bf16x8*qr,const f32x16&c0,const f32x16&c1,int r32,int hi){
  const char*kb=Kslot+hi*1024+r32*16;
  #pragma unroll
  for(int d0=0;d0<4;++d0){
    const bf16x8 b0=*reinterpret_cast<const bf16x8*>(kb+d0*2048);
    const bf16x8 b1=*reinterpret_cast<const bf16x8*>(kb+d0*2048+512);
    if(d0==0){p0=__builtin_amdgcn_mfma_f32_32x32x16_bf16(b0,qr[0],c0,0,0,0);p1=__builtin_amdgcn_mfma_f32_32x32x16_bf16(b1,qr[0],c1,0,0,0);}
    else{p0=__builtin_amdgcn_mfma_f32_32x32x16_bf16(b0,qr[d0],p0,0,0,0);p1=__builtin_amdgcn_mfma_f32_32x32x16_bf16(b1,qr[d0],p1,0,0,0);}}
}
typedef __attribute__((address_space(3))) const char* lds_cptr;
typedef short v4i16_t __attribute__((ext_vector_type(4)));
__device__ __forceinline__ void kload8(bf16x8*kf,lds_cptr kp){
  kf[0]=*(const __attribute__((address_space(3))) bf16x8*)(kp);      kf[1]=*(const __attribute__((address_space(3))) bf16x8*)(kp+512);
  kf[2]=*(const __attribute__((address_space(3))) bf16x8*)(kp+2048); kf[3]=*(const __attribute__((address_space(3))) bf16x8*)(kp+2560);
  kf[4]=*(const __attribute__((address_space(3))) bf16x8*)(kp+4096); kf[5]=*(const __attribute__((address_space(3))) bf16x8*)(kp+4608);
  kf[6]=*(const __attribute__((address_space(3))) bf16x8*)(kp+6144); kf[7]=*(const __attribute__((address_space(3))) bf16x8*)(kp+6656);
}
__device__ __forceinline__ void kload2(bf16x8*kf,lds_cptr kp,int j){ kf[2*j]=*(const __attribute__((address_space(3))) bf16x8*)(kp+j*2048); kf[2*j+1]=*(const __attribute__((address_space(3))) bf16x8*)(kp+j*2048+512); }
__device__ __forceinline__ s16x4 vtr(lds_cptr p){ return __builtin_bit_cast(s16x4,__builtin_amdgcn_ds_read_tr16_b64_v4i16((__attribute__((address_space(3))) v4i16_t*)p)); }
__device__ __forceinline__ float rowmax(const f32x16&p0,const f32x16&p1){
  float a=max3f(p0[0],p0[1],p1[0]),b=max3f(p0[2],p0[3],p1[1]);a=max3f(a,p1[2],p1[3]);
  #pragma unroll
  for(int r=4;r<16;r+=4){a=max3f(a,p0[r],p0[r+1]);b=max3f(b,p0[r+2],p0[r+3]);a=max3f(a,p1[r],p1[r+1]);b=max3f(b,p1[r+2],p1[r+3]);}
  const float m=max2f(a,b);
  auto rr=__builtin_amdgcn_permlane32_swap(__float_as_uint(m),__float_as_uint(m),false,false);
  return max2f(__uint_as_float(rr[0]),__uint_as_float(rr[1]));
}
__device__ __forceinline__ void pv(f32x16*o,int vb,bf16x8 pa0,bf16x8 pa1,bf16x8 pa2,bf16x8 pa3){
  #pragma unroll
  for(int d0=0;d0<2;++d0){s16x4 lo[4],hi[4];
    #pragma unroll
    for(int ks=0;ks<4;++ks){
      asm volatile("ds_read_b64_tr_b16 %0,%1 offset:%c2":"=&v"(lo[ks]):"v"(vb),"i"(d0*4096+ks*1024):"memory");
      asm volatile("ds_read_b64_tr_b16 %0,%1 offset:%c2":"=&v"(hi[ks]):"v"(vb),"i"(d0*4096+ks*1024+512):"memory");}
    asm volatile("s_waitcnt lgkmcnt(0)":::"memory");SBAR();
    #define PK(k) (bf16x8){lo[k][0],lo[k][1],lo[k][2],lo[k][3],hi[k][0],hi[k][1],hi[k][2],hi[k][3]}
    o[d0]=__builtin_amdgcn_mfma_f32_32x32x16_bf16(pa0,PK(0),o[d0],0,0,0);
    o[d0]=__builtin_amdgcn_mfma_f32_32x32x16_bf16(pa1,PK(1),o[d0],0,0,0);
    o[d0]=__builtin_amdgcn_mfma_f32_32x32x16_bf16(pa2,PK(2),o[d0],0,0,0);
    o[d0]=__builtin_amdgcn_mfma_f32_32x32x16_bf16(pa3,PK(3),o[d0],0,0,0);
    #undef PK
  }
}

#ifndef ATTN_STORE16
#define ATTN_STORE16(p,v) (*(u32x4*)(p)=(v))
#endif
template<int THRL,bool CAUSAL,bool BIAS,int PQ,int PKV,bool REV=false,bool SKIP=false> __device__ __forceinline__ void attn_unit(const bf16*Q0,const bf16*__restrict__ Kh,const bf16*__restrict__ Vh,bf16*O0,const int NTI,lds_f4p btab,char*shm,float kmaxv=0.f,__attribute__((address_space(3))) float*xq=nullptr){
  int NT=NTI;
  int tid_o=threadIdx.x; asm volatile("":"+v"(tid_o)); const int tid=tid_o,lane=tid&63,r32=lane&31,hi=lane>>5; const int wid=__builtin_amdgcn_readfirstlane(tid>>6);
  const bf16*Qw=Q0+(long)(wid*QBLK)*PQ;
  const unsigned lds0=(unsigned)(uintptr_t)shm;
  float*wsf=(float*)(shm+LDS_WS)+wid*64;
  const bf16*ksrc=Kh+(long)lane*PKV+wid*8;
  const bf16*vsrc=Vh+(long)(16*(wid&3)+(lane>>2))*PKV+(wid>>2)*32+(lane&3)*8;
  const unsigned kdst=lds0+LDS_K+wid*1024, vdst=lds0+LDS_V+wid*1024;
  #define TIX(t) (REV?(NTI-1-(t)):(t))
  #define DMA_K(t,slot) glds16(ksrc+(long)TIX(t)*KVBLK*PKV,(unsigned)__builtin_amdgcn_readfirstlane(kdst+(slot)))
  #define DMA_V(t,slot) glds16(vsrc+(long)TIX(t)*KVBLK*PKV,(unsigned)__builtin_amdgcn_readfirstlane(vdst+(slot)))
  const int vb0=(int)(lds0+LDS_V)+((lane>>4)&1)*32+(lane&3)*8+(4*hi+((lane&15)>>2))*64;
  const char*Kbase=shm+LDS_K; bf16x8 kf[8];
  const lds_cptr shm3=(lds_cptr)shm; const lds_cptr kp0=shm3+LDS_K+hi*1024+r32*16; const lds_cptr vp0=shm3+LDS_V+((lane>>4)&1)*32+(lane&3)*8+(4*hi+((lane&15)>>2))*64;
  DMA_K(0,0);DMA_V(0,0);DMA_K(1,SLOTB);
  bf16x8 qr[4];
  #pragma unroll
  for(int d0=0;d0<4;++d0)qr[d0]=*reinterpret_cast<const bf16x8*>(&Qw[(long)r32*PQ+d0*16+hi*8]);
  if(SKIP){ float qsq=0.f;
    _Pragma("unroll") for(int d0=0;d0<4;++d0) _Pragma("unroll") for(int e=0;e<8;++e){ const float f=__uint_as_float(((unsigned)(unsigned short)qr[d0][e])<<16); qsq+=f*f; }
    { auto rr=__builtin_amdgcn_permlane32_swap(__float_as_uint(qsq),__float_as_uint(qsq),false,false); qsq=__uint_as_float(rr[0])+__uint_as_float(rr[1]); }
    _Pragma("unroll") for(int o_=1;o_<32;o_<<=1) qsq=__builtin_fmaxf(qsq,__shfl_xor(qsq,o_));
    if(lane==0) xq[wid]=qsq; }
  float mhat=0.f,l_reg=0.f;f32x16 o[2];o[0]=f32x16{};o[1]=f32x16{};f32x16 negm=f32x16{}; if(!BIAS){asm volatile("":"+v"(negm));}
  const int qrel=wid*QBLK+r32;
  #define CMASK(P0,P1,t) do{ if(CAUSAL){int jb_=REV?3-(t):(t)-(NT-4); if(jb_>=0)cmask(P0,P1,jb_,qrel,hi);} }while(0)
  bool resc=false;
  #define START(P0,P1) do{ const float rm=rowmax(P0,P1); resc=false; \
    { const float dl=(rm==-INFINITY)?0.f:rm; mhat=fadd_s(mhat,dl); \
      _Pragma("unroll") for(int r=0;r<16;++r){P0[r]=fsub_s(P0[r],dl);P1[r]=fsub_s(P1[r],dl);} \
      if(!BIAS){ _Pragma("unroll") for(int r=0;r<16;++r)negm[r]=-mhat; asm volatile("":"+v"(negm)); } } \
    _Pragma("unroll") for(int r=0;r<16;++r)P0[r]=__builtin_amdgcn_exp2f(P0[r]); }while(0)
  #define RESC() do{ if(resc){ asm volatile("s_waitcnt lgkmcnt(0)":::"memory"); \
      _Pragma("unroll") for(int d_=0;d_<2;++d_) _Pragma("unroll") for(int r=0;r<16;++r)o[d_][r]*=wsf[crow(r,hi)]; } }while(0)
  #define BFILL(C0,C1,t) do{ if(BIAS){ const lds_f4p bt_=btab+TIX(t)*16+hi; \
    _Pragma("unroll") for(int j_=0;j_<4;++j_){ const f32x4_t v0_=bt_[2*j_], v1_=bt_[2*j_+8]; \
      C0[4*j_]=v0_[0]-mhat; C0[4*j_+1]=v0_[1]-mhat; C0[4*j_+2]=v0_[2]-mhat; C0[4*j_+3]=v0_[3]-mhat; \
      C1[4*j_]=v1_[0]-mhat; C1[4*j_+1]=v1_[1]-mhat; C1[4*j_+2]=v1_[2]-mhat; C1[4*j_+3]=v1_[3]-mhat; } } }while(0)
  f32x16 pA0,pA1,pB0,pB1;
  int sl_prev=0,sl_cur=0,sl_next=SLOTB;
  #define ROT() do{sl_prev=sl_cur;sl_cur=sl_next;sl_next=(sl_next==(NSLOT-1)*SLOTB)?0:sl_next+SLOTB;}while(0)
  DMA_K(2,2*SLOTB);
  WAIT_BAR(3);
  if(SKIP){
    float q2=xq[0]; _Pragma("unroll") for(int w_=1;w_<8;++w_) q2=__builtin_fmaxf(q2,xq[w_]);
    const float qk2=2.f*__builtin_sqrtf(q2)*kmaxv; const __attribute__((address_space(3))) float*bf_=(const __attribute__((address_space(3))) float*)btab; const float bq0=bf_[64*(NTI-4)];
    for(int c_=4;c_<NTI;c_+=2){ if(bf_[64*(NTI-c_)-1]-bq0+qk2<-170.f){ NT=c_; break; } } }
  BFILL(pA0,pA1,0); qkt(pA0,pA1,Kbase,qr,BIAS?pA0:negm,BIAS?pA1:negm,r32,hi);asm volatile("s_nop 15\n\ts_nop 7":"+v"(pA0),"+v"(pA1));CMASK(pA0,pA1,0);
  START(pA0,pA1);
  BFILL(pB0,pB1,1);
  _Pragma("unroll") for(int r=0;r<16;++r)pA1[r]=__builtin_amdgcn_exp2f(pA1[r]);
  WAIT_BAR(0);
  DMA_K(3,0);DMA_V(1,SLOTB);
  ROT();
  kload8(kf,kp0+sl_cur);
  WAIT_BAR(2);
  s16x4 vlo[8],vhi[8]; u32x4 pw0,pw1,pw2,pw3;
  #define PKW(P,B) cvtpk_s(P[B],P[B+1])
  #define PAF(k) __builtin_bit_cast(bf16x8,pw##k)
  #define VFR(i) (bf16x8){vlo[i][0],vlo[i][1],vlo[i][2],vlo[i][3],vhi[i][0],vhi[i][1],vhi[i][2],vhi[i][3]}
  #define PIN(x) asm volatile("":"+v"(x))
  #define MX3(a,b,c) __builtin_fmaxf(__builtin_fmaxf((a),(b)),(c))
  #define GAPA(MF,A0,A1,A2,A3,W0,W1,PW) do{ MF; sacc+=A0; sacc+=A1; sacc+=A2; sacc+=A3; PIN(sacc); W0; W1; PIN(PW); SBAR(); }while(0)
  #define EX(v) __builtin_amdgcn_exp2f(v)
  #define GAPB(MF,X,B,FL,PN,JJ,OFFN) do{ MF; X[B]=EX(X[B]); X[B+1]=EX(X[B+1]); X[B+2]=EX(X[B+2]); X[B+3]=EX(X[B+3]); \
    if(BIAS&&(FL)){ { f32x2_t a_={bq_[0],bq_[1]}, b_={bq_[2],bq_[3]}; const f32x2_t m2_={mhat,mhat}; a_-=m2_; b_-=m2_; PN[4*(JJ)]=a_[0]; PN[4*(JJ)+1]=a_[1]; PN[4*(JJ)+2]=b_[0]; PN[4*(JJ)+3]=b_[1]; } if((OFFN)>=0) bq_=btn_[(OFFN)>=0?(OFFN):0]; PIN(PN); } PIN(X); SBAR(); }while(0)
  #define VRD(i) do{ vlo[i]=vtr(vp_+(((i)>>2)*4096+((i)&3)*1024)); vhi[i]=vtr(vp_+(((i)>>2)*4096+((i)&3)*1024+512)); }while(0)
  #define KRD(G,j) do{ if(G){ kload2(kf,kp0+sl_next,j); SBAR(); } }while(0)
  #define STEP(C0,C1,P0,P1,t,GK,GV,GL) do{ SBAR(); \
    const lds_cptr vp_=vp0+sl_prev; \
    VRD(0); SBAR(); float sacc=(P0[0]+P0[1]); \
    GAPA(C0=__builtin_amdgcn_mfma_f32_32x32x16_bf16(kf[0],qr[0],BIAS?C0:negm,0,0,0), P0[2],P0[3],P0[4],P0[5],     pw0[0]=PKW(P0,0), pw0[1]=PKW(P0,2), pw0); \
    VRD(4); SBAR(); GAPA(C1=__builtin_amdgcn_mfma_f32_32x32x16_bf16(kf[1],qr[0],BIAS?C1:negm,0,0,0), P0[6],P0[7],P0[8],P0[9],     pw0[2]=PKW(P0,4), pw0[3]=PKW(P0,6), pw0); \
    VRD(1); SBAR(); GAPA(C0=__builtin_amdgcn_mfma_f32_32x32x16_bf16(kf[2],qr[1],C0,0,0,0),   P0[10],P0[11],P0[12],P0[13], pw1[0]=PKW(P0,8), pw1[1]=PKW(P0,10), pw1); \
    VRD(5); SBAR(); GAPA(C1=__builtin_amdgcn_mfma_f32_32x32x16_bf16(kf[3],qr[1],C1,0,0,0),   P0[14],P0[15],P1[0],P1[1],   pw1[2]=PKW(P0,12),pw1[3]=PKW(P0,14), pw1); \
    VRD(2); SBAR(); GAPA(C0=__builtin_amdgcn_mfma_f32_32x32x16_bf16(kf[4],qr[2],C0,0,0,0),   P1[2],P1[3],P1[4],P1[5],     pw2[0]=PKW(P1,0), pw2[1]=PKW(P1,2), pw2); \
    VRD(6); SBAR(); GAPA(C1=__builtin_amdgcn_mfma_f32_32x32x16_bf16(kf[5],qr[2],C1,0,0,0),   P1[6],P1[7],P1[8],P1[9],     pw2[2]=PKW(P1,4), pw2[3]=PKW(P1,6), pw2); \
    VRD(3); SBAR(); GAPA(C0=__builtin_amdgcn_mfma_f32_32x32x16_bf16(kf[6],qr[3],C0,0,0,0),   P1[10],P1[11],P1[12],P1[13], pw3[0]=PKW(P1,8), pw3[1]=PKW(P1,10), pw3); \
    VRD(7); SBAR(); GAPA(C1=__builtin_amdgcn_mfma_f32_32x32x16_bf16(kf[7],qr[3],C1,0,0,0),   P1[14],P1[15],0.f,0.f,       pw3[2]=PKW(P1,12),pw3[3]=PKW(P1,14), pw3); \
    l_reg+=sacc; \
    if(GK){DMA_K((t)+3,sl_cur);} if(GV){DMA_V((t)+1,sl_next);} \
    CMASK(C0,C1,t); \
    { float a=MX3(C0[0],C0[1],C1[0]),b=MX3(C0[2],C0[3],C1[1]); a=MX3(a,C1[2],C1[3]); \
      _Pragma("unroll") for(int r=4;r<16;r+=4){a=MX3(a,C0[r],C0[r+1]);b=MX3(b,C0[r+2],C0[r+3]);a=MX3(a,C1[r],C1[r+1]);b=MX3(b,C1[r+2],C1[r+3]);} \
      float rm=__builtin_fmaxf(a,b); { auto rr=__builtin_amdgcn_permlane32_swap(__float_as_uint(rm),__float_as_uint(rm),false,false); rm=__builtin_fmaxf(__uint_as_float(rr[0]),__uint_as_float(rr[1])); } \
      resc=false; \
      if(__builtin_expect(__any(rm>(float)THRL),0)){ const float dl=__builtin_fmaxf(rm,0.f); mhat+=dl; \
        _Pragma("unroll") for(int r=0;r<16;++r){C0[r]-=dl;C1[r]-=dl;} \
        if(!BIAS){ _Pragma("unroll") for(int r=0;r<16;++r)negm[r]=-mhat; asm volatile("":"+v"(negm)); } \
        const float f=__builtin_amdgcn_exp2f(-dl); l_reg*=f; if(hi==0)wsf[r32]=f; resc=true; } } \
    const lds_f4p btn_=btab+TIX((t)+1)*16+hi; f32x4_t bq_; if(BIAS&&(GL)) bq_=btn_[0]; \
    SBAR(); \
    GAPB(o[0]=__builtin_amdgcn_mfma_f32_32x32x16_bf16(PAF(0),VFR(0),o[0],0,0,0), C0,0, GL,P0,0,2); \
    GAPB(o[1]=__builtin_amdgcn_mfma_f32_32x32x16_bf16(PAF(0),VFR(4),o[1],0,0,0), C0,4, GL,P0,1,4); \
    KRD(GL,0); GAPB(o[0]=__builtin_amdgcn_mfma_f32_32x32x16_bf16(PAF(1),VFR(1),o[0],0,0,0), C0,8, GL,P0,2,6); \
    KRD(GL,1); GAPB(o[1]=__builtin_amdgcn_mfma_f32_32x32x16_bf16(PAF(1),VFR(5),o[1],0,0,0), C0,12, GL,P0,3,8); \
    KRD(GL,2); GAPB(o[0]=__builtin_amdgcn_mfma_f32_32x32x16_bf16(PAF(2),VFR(2),o[0],0,0,0), C1,0, GL,P1,0,10); \
    KRD(GL,3); GAPB(o[1]=__builtin_amdgcn_mfma_f32_32x32x16_bf16(PAF(2),VFR(6),o[1],0,0,0), C1,4, GL,P1,1,12); \
    GAPB(o[0]=__builtin_amdgcn_mfma_f32_32x32x16_bf16(PAF(3),VFR(3),o[0],0,0,0), C1,8, GL,P1,2,14); \
    GAPB(o[1]=__builtin_amdgcn_mfma_f32_32x32x16_bf16(PAF(3),VFR(7),o[1],0,0,0), C1,12, GL,P1,3,-1); \
    }while(0)
  int t=1;
  #undef CMASK
  #define CMASK(P0,P1,t) do{ if(REV&&CAUSAL){int jb_=3-(t); if(jb_>=0)cmask(P0,P1,jb_,qrel,hi);} }while(0)
  for(;t+5<NT;t+=2){
    STEP(pB0,pB1,pA0,pA1,t,true,true,true);     WAIT_BAR(2); RESC(); ROT();
    STEP(pA0,pA1,pB0,pB1,t+1,true,true,true);   WAIT_BAR(2); RESC(); ROT();
  }
  #undef CMASK
  #define CMASK(P0,P1,t) do{ if(CAUSAL){int jb_=REV?3-(t):(t)-(NT-4); if(jb_>=0)cmask(P0,P1,jb_,qrel,hi);} }while(0)
  #define ENDW(tt) do{ if((tt)+3<NT){WAIT_BAR(2);} else if((tt)+2<NT){WAIT_BAR(1);} else {WAIT_BAR(0);} }while(0)
  for(;t+1<NT;t+=2){
    STEP(pB0,pB1,pA0,pA1,t,(t+3<NT),(t+1<NT),(t+1<NT));       ENDW(t);   RESC(); ROT();
    STEP(pA0,pA1,pB0,pB1,t+1,(t+4<NT),(t+2<NT),(t+2<NT));     ENDW(t+1); RESC(); ROT();
  }
  STEP(pB0,pB1,pA0,pA1,NT-1,false,false,false); RESC();
  { float sacc=pB0[0]+pB0[1]; _Pragma("unroll") for(int r=2;r<16;++r)sacc+=pB0[r]; _Pragma("unroll") for(int r=0;r<16;++r)sacc+=pB1[r]; l_reg+=sacc;
    pw0=(u32x4){PKW(pB0,0),PKW(pB0,2),PKW(pB0,4),PKW(pB0,6)};pw1=(u32x4){PKW(pB0,8),PKW(pB0,10),PKW(pB0,12),PKW(pB0,14)};pw2=(u32x4){PKW(pB1,0),PKW(pB1,2),PKW(pB1,4),PKW(pB1,6)};pw3=(u32x4){PKW(pB1,8),PKW(pB1,10),PKW(pB1,12),PKW(pB1,14)};
    SBAR(); pv(o,vb0+sl_cur,PAF(0),PAF(1),PAF(2),PAF(3)); }
  #undef PKW
  #undef PAF
  #undef VFR
  #undef PIN
  #undef MX3
  #undef GAPA
  #undef GAPB
  #undef EX
  #undef VRD
  #undef KRD
  #undef STEP
  #undef ENDW
  {auto rr=__builtin_amdgcn_permlane32_swap(__float_as_uint(l_reg),__float_as_uint(l_reg),false,false);l_reg=__uint_as_float(rr[0])+__uint_as_float(rr[1]);}
  if(hi==0)wsf[32+r32]=l_reg;asm volatile("s_waitcnt lgkmcnt(0)":::"memory");
  float rli[16];
  #pragma unroll
  for(int r=0;r<16;++r)rli[r]=__builtin_amdgcn_rcpf(wsf[32+crow(r,hi)]);
  bf16*Ow=O0+(long)(wid*QBLK)*PQ;
  { bf16*stg=(bf16*)(shm+LDS_OST)+wid*2048;
    #pragma unroll
    for(int r=0;r<16;++r){const int orow=crow(r,hi);
      #pragma unroll
      for(int d0=0;d0<2;++d0)stg[orow*64+d0*32+r32]=__float2bfloat16(o[d0][r]*rli[r]);}
    asm volatile("s_waitcnt lgkmcnt(0)":::"memory");
    #pragma unroll
    for(int i=0;i<4;++i){const int row=i*8+(lane>>3),ch=lane&7; const u32x4 v=*(const u32x4*)(stg+row*64+ch*8); ATTN_STORE16(Ow+(long)row*PQ+ch*8,v);} }
  asm volatile("s_waitcnt lgkmcnt(0)\n\ts_barrier":::"memory");
  #undef DMA_K
  #undef DMA_V
  #undef CMASK
  #undef START
  #undef RESC
  #undef ROT
  #undef TIX
  #undef BFILL
}

#undef SBAR
#undef WAIT_BAR
}

#define LAS __attribute__((address_space(3)))
typedef unsigned short bf16_t;
typedef pg8::f32x4 f32x4;
typedef pg8::u32x4 u32x4;
typedef attn_body::bf16 abf16;

constexpr int NB = 8, SEQ = 4096, DM = 1024, NTOK = NB * SEQ, DTOK = 768, NGRP = 48, DFF = 2816, MEMT = 256, NHEAD = 12;
constexpr float EPS = 1e-6f, LOG2E = 1.4426950408889634f, C2 = 0.125f * 1.4426950408889634f, INV2PI = 0.15915494309189535f;
constexpr int NTHREADS = 512, NWAVES = 8;
constexpr int LDS_BYTES = 147456;
constexpr int LDS_BTAB = 98304, LDS_WSUM = 114688;

constexpr size_t MiB = (size_t)1 << 20;
constexpr size_t WS_SS = 0;
constexpr size_t WS_LOGF = 1 * MiB;
constexpr size_t WS_KMAX = 3 * MiB + 65536;
constexpr size_t WS_BAR = 3 * MiB;
constexpr size_t WS_WIN0 = 4 * MiB, WS_WOUT0 = 6 * MiB, WS_WOUT1 = 8 * MiB, WS_WUP0 = 10 * MiB, WS_WUP1 = 21 * MiB;
constexpr size_t WS_WDN0 = 32 * MiB, WS_WDN1 = 38 * MiB, WS_WGLU = 44 * MiB, WS_WKVQ = 46 * MiB, WS_WMKV0 = 51 * MiB, WS_WMKV1 = 52 * MiB;
constexpr size_t WS_BT1 = 53 * MiB, WS_BT3 = 59 * MiB, WS_MEMN = 68 * MiB, WS_MEMKV0 = 72 * MiB, WS_MEMKV1 = 74 * MiB;
constexpr size_t WS_HB = 76 * MiB;
constexpr size_t WS_R = 140 * MiB;
constexpr size_t WS_PROJ0 = WS_R, WS_A3 = WS_R + 64 * MiB, WS_SLOC = WS_R + 136 * MiB, WS_GB = WS_R + 184 * MiB, WS_TOKMIX = WS_R + 232 * MiB;
constexpr size_t WS_ABUF = WS_R, WS_GBUF = WS_R + 176 * MiB;
constexpr size_t WS_KV = WS_R, WS_PROJ1 = WS_R + 96 * MiB;
constexpr size_t WS_END = WS_R + 352 * MiB;

__device__ __forceinline__ unsigned pk2(float lo, float hi) { return pg8::cvt_pk_bf16(lo, hi); }
__device__ __forceinline__ float bf_lo(unsigned w) { return __uint_as_float(w << 16); }
__device__ __forceinline__ float bf_hi(unsigned w) { return __uint_as_float(w & 0xffff0000u); }
__device__ __forceinline__ bf16_t f2bf(float f) { return (bf16_t)(pk2(f, 0.f) & 0xffffu); }
__device__ __forceinline__ float wave_sum(float v) {
#pragma unroll
    for (int o = 1; o < 64; o <<= 1) v += __shfl_xor(v, o);
    return v;
}
__device__ __forceinline__ float fexp(float x) { return __builtin_amdgcn_exp2f(x * LOG2E); }
__device__ __forceinline__ float frcp(float x) { return __builtin_amdgcn_rcpf(x); }
__device__ __forceinline__ float sigm(float x) { return frcp(1.f + fexp(-x)); }
__device__ __forceinline__ float gelu_tanh(float x) {
    const float z = 0.7978845608028654f * (x + 0.044715f * x * x * x);
    const float e = fexp(2.f * z);
    const float th = 1.f - 2.f * frcp(1.f + e);
    return 0.5f * x * (1.f + th);
}
__device__ __forceinline__ float rstd_of(float ss) { return __builtin_amdgcn_rsqf(ss * (1.f / 1024.f) + EPS); }
__device__ __forceinline__ void unpack8(const u32x4 w, float (&f)[8]) {
    f[0] = bf_lo(w.x); f[1] = bf_hi(w.x); f[2] = bf_lo(w.y); f[3] = bf_hi(w.y); f[4] = bf_lo(w.z); f[5] = bf_hi(w.z); f[6] = bf_lo(w.w); f[7] = bf_hi(w.w);
}
__device__ __forceinline__ u32x4 pack8(const float (&f)[8]) { u32x4 w; w.x = pk2(f[0], f[1]); w.y = pk2(f[2], f[3]); w.z = pk2(f[4], f[5]); w.w = pk2(f[6], f[7]); return w; }

#define LOAD_RS8(rs, ss) float rs[2][4]; { float t_[2][4]; _Pragma("unroll") for (int ai = 0; ai < 2; ++ai) _Pragma("unroll") for (int mm = 0; mm < 4; ++mm) t_[ai][mm] = (ss)[u.pm * 256 + ai * 128 + wr * 64 + mm * 16 + fr]; \
    _Pragma("unroll") for (int ai = 0; ai < 2; ++ai) _Pragma("unroll") for (int mm = 0; mm < 4; ++mm) rs[ai][mm] = rstd_of(t_[ai][mm]); }
#define EPI_ROWS(...) _Pragma("unroll") for (int ai = 0; ai < 2; ++ai) _Pragma("unroll") for (int m = 0; m < 4; ++m) { const int row = u.pm * 256 + ai * 128 + wr * 64 + m * 16 + fr; __VA_ARGS__ asm volatile("" ::: "memory"); }
typedef const f32x4 (&AccRef)[2][2][4][2];

struct EpiStore {
    static constexpr bool PERM = true, AFTER_DRAIN = false;
    const float* ss; bf16_t* o0; int ld0; int split; bf16_t* o1; int ld1;
    __device__ __forceinline__ void operator()(AccRef acc, const pg8::Unit& u, int wr, int wc, int fr, int fq) const {
        asm volatile("" : "+v"(fr), "+v"(fq));
        const int colt = u.pn * 256; bf16_t* base; int ld, cb;
        if (colt < split) { base = o0; ld = ld0; cb = colt; } else { base = o1; ld = ld1; cb = colt - split; }
        const int col0 = cb + wc * 32 + 8 * fq;
        float rsv[2][4];
        if (ss) { LOAD_RS8(r8, ss) _Pragma("unroll") for (int ai = 0; ai < 2; ++ai) _Pragma("unroll") for (int mm = 0; mm < 4; ++mm) rsv[ai][mm] = r8[ai][mm]; }
        else { _Pragma("unroll") for (int ai = 0; ai < 2; ++ai) _Pragma("unroll") for (int mm = 0; mm < 4; ++mm) rsv[ai][mm] = 1.f; }
        EPI_ROWS(
            const float rs = rsv[ai][m]; bf16_t* rp = base + (size_t)row * ld + col0;
            _Pragma("unroll") for (int bj = 0; bj < 2; ++bj) { const f32x4 v0 = acc[ai][bj][m][0] * rs, v1 = acc[ai][bj][m][1] * rs;
                u32x4 w; w.x = pk2(v0[0], v0[1]); w.y = pk2(v0[2], v0[3]); w.z = pk2(v1[0], v1[1]); w.w = pk2(v1[2], v1[3]); *(u32x4*)(rp + bj * 128) = w; }
        )
    }
};
struct EpiKVQ {
    static constexpr bool PERM = true, AFTER_DRAIN = false;
    const float* ss; bf16_t* kv; bf16_t* proj; unsigned* kmax;
    __device__ __forceinline__ void operator()(AccRef acc, const pg8::Unit& u, int wr, int wc, int fr, int fq) const {
        asm volatile("" : "+v"(fr), "+v"(fq));
        const bool isq = u.pn >= 6; bf16_t* base = isq ? proj : kv; const int ld = isq ? 1024 : 1536, col0 = (isq ? u.pn * 256 - 1536 : u.pn * 256) + wc * 32 + 8 * fq;
        LOAD_RS8(rsv, ss)
        float mx[2] = {0.f, 0.f};
        EPI_ROWS(
            const float rs = rsv[ai][m]; bf16_t* rp = base + (size_t)row * ld + col0;
            _Pragma("unroll") for (int bj = 0; bj < 2; ++bj) { const f32x4 v0 = acc[ai][bj][m][0] * rs, v1 = acc[ai][bj][m][1] * rs;
                u32x4 w; w.x = pk2(v0[0], v0[1]); w.y = pk2(v0[2], v0[3]); w.z = pk2(v1[0], v1[1]); w.w = pk2(v1[2], v1[3]); *(u32x4*)(rp + bj * 128) = w;
                if (u.pn < 3) { float sq = (v0[0] * v0[0] + v0[1] * v0[1]) + (v0[2] * v0[2] + v0[3] * v0[3]) + (v1[0] * v1[0] + v1[1] * v1[1]) + (v1[2] * v1[2] + v1[3] * v1[3]);
                    sq += __shfl_xor(sq, 16); sq += __shfl_xor(sq, 32); mx[bj] = fmaxf(mx[bj], sq); } }
        )
        if (u.pn < 3) {
#pragma unroll
            for (int bj = 0; bj < 2; ++bj) { float v = mx[bj];
#pragma unroll
                for (int o = 1; o < 16; o <<= 1) v = fmaxf(v, __shfl_xor(v, o));
                if (fr == 0 && fq == 0) { const int b = (u.pm * 256) >> 12, h = u.pn * 4 + bj * 2 + (wc >> 1);
                    __hip_atomic_fetch_max(kmax + (b * NHEAD + h) * 2 + (wc & 1), __float_as_uint(v), __ATOMIC_RELAXED, __HIP_MEMORY_SCOPE_AGENT); } }
        }
    }
};
struct EpiIn0 {
    static constexpr bool PERM = true, AFTER_DRAIN = false;
    const float* ss; bf16_t* A3; bf16_t* proj;
    __device__ __forceinline__ void operator()(AccRef acc, const pg8::Unit& u, int wr, int wc, int fr, int fq) const {
        asm volatile("" : "+v"(fr), "+v"(fq));
        const int colt = u.pn * 256;
        LOAD_RS8(rsv, ss)
        EPI_ROWS(
            const float rs = rsv[ai][m];
            _Pragma("unroll") for (int bj = 0; bj < 2; ++bj) { const f32x4 v0 = acc[ai][bj][m][0] * rs, v1 = acc[ai][bj][m][1] * rs;
                u32x4 w; w.x = pk2(v0[0], v0[1]); w.y = pk2(v0[2], v0[3]); w.z = pk2(v1[0], v1[1]); w.w = pk2(v1[2], v1[3]);
                const int col = colt + bj * 128 + wc * 32 + 8 * fq;
                bf16_t* dst = (colt < DTOK) ? A3 + ((size_t)((col >> 4) * 2048 + (row >> 4)) * 384 + (row & 15) * 16 + (col & 15)) : proj + (size_t)row * 1024 + col;
                *(u32x4*)dst = w; }
        )
    }
};
struct EpiS1 {
    static constexpr bool PERM = true, AFTER_DRAIN = false;
    float* sloc;
    __device__ __forceinline__ void operator()(AccRef acc, const pg8::Unit& u, int wr, int wc, int fr, int fq) const {
        asm volatile("" : "+v"(fr), "+v"(fq));
        EPI_ROWS( float* p = sloc + (size_t)row * 128 + wc * 32 + 8 * fq; *(f32x4*)p = acc[ai][0][m][0]; *(f32x4*)(p + 4) = acc[ai][0][m][1]; )
    }
};
struct EpiS3 {
    static constexpr bool PERM = true, AFTER_DRAIN = false;
    bf16_t* gb;
    __device__ __forceinline__ void operator()(AccRef acc, const pg8::Unit& u, int wr, int wc, int fr, int fq) const {
        asm volatile("" : "+v"(fr), "+v"(fq));
        const int g = u.pn;
        EPI_ROWS(
            const int rl = row & 2047;
            _Pragma("unroll") for (int bj = 0; bj < 2; ++bj) { const int colL = bj * 128 + wc * 32 + 8 * fq, s = colL >> 4, i0 = colL & 15;
                const f32x4 a0 = acc[ai][bj][m][0], a1 = acc[ai][bj][m][1]; u32x4 w;
                w.x = pk2(gelu_tanh(a0[0]), gelu_tanh(a0[1])); w.y = pk2(gelu_tanh(a0[2]), gelu_tanh(a0[3]));
                w.z = pk2(gelu_tanh(a1[0]), gelu_tanh(a1[1])); w.w = pk2(gelu_tanh(a1[2]), gelu_tanh(a1[3]));
                *(u32x4*)(gb + (size_t)(rl * 16 + s) * DTOK + g * 16 + i0) = w; }
        )
    }
};
struct EpiGlu {
    static constexpr bool PERM = true, AFTER_DRAIN = false;
    const bf16_t* gb; bf16_t* tokmix;
    __device__ __forceinline__ void operator()(AccRef acc, const pg8::Unit& u, int wr, int wc, int fr, int fq) const {
        asm volatile("" : "+v"(fr), "+v"(fq));
#pragma unroll
        for (int ai = 0; ai < 2; ++ai) {
            u32x4 gw[4][2];
#pragma unroll
            for (int m = 0; m < 4; ++m)
#pragma unroll
                for (int bj = 0; bj < 2; ++bj) gw[m][bj] = *(const u32x4*)(gb + (size_t)(u.pm * 256 + ai * 128 + wr * 64 + m * 16 + fr) * DTOK + u.pn * 256 + bj * 128 + wc * 32 + 8 * fq);
#pragma unroll
            for (int m = 0; m < 4; ++m)
#pragma unroll
                for (int bj = 0; bj < 2; ++bj) { const int row = u.pm * 256 + ai * 128 + wr * 64 + m * 16 + fr, col0 = u.pn * 256 + bj * 128 + wc * 32 + 8 * fq;
                    float gf[8]; unpack8(gw[m][bj], gf); const f32x4 a0 = acc[ai][bj][m][0], a1 = acc[ai][bj][m][1]; float y[8];
#pragma unroll
                    for (int j = 0; j < 4; ++j) { y[j] = gf[j] * sigm(a0[j]); y[4 + j] = gf[4 + j] * sigm(a1[j]); }
                    *(u32x4*)(tokmix + (size_t)row * 1024 + col0) = pack8(y); }
            asm volatile("" ::: "memory");
        }
    }
};
template <bool BASE_BF16, bool WRITE_F32>
struct EpiRes {
    static constexpr bool PERM = true, AFTER_DRAIN = false;
    const void* base; float* out; bf16_t* hb; float* ss;
    __device__ __forceinline__ void operator()(AccRef acc, const pg8::Unit& u, int wr, int wc, int fr, int fq) const {
        asm volatile("" : "+v"(fr), "+v"(fq));
#pragma unroll
        for (int ai = 0; ai < 2; ++ai) {
            f32x4 bv[4][2][2];
#pragma unroll
            for (int m = 0; m < 4; ++m)
#pragma unroll
                for (int bj = 0; bj < 2; ++bj) { const size_t off = (size_t)(u.pm * 256 + ai * 128 + wr * 64 + m * 16 + fr) * 1024 + u.pn * 256 + bj * 128 + wc * 32 + 8 * fq;
                    if (BASE_BF16) { const u32x4 w = *(const u32x4*)((const bf16_t*)base + off);
                        bv[m][bj][0] = (f32x4){bf_lo(w.x), bf_hi(w.x), bf_lo(w.y), bf_hi(w.y)}; bv[m][bj][1] = (f32x4){bf_lo(w.z), bf_hi(w.z), bf_lo(w.w), bf_hi(w.w)}; }
                    else { bv[m][bj][0] = *(const f32x4*)((const float*)base + off); bv[m][bj][1] = *(const f32x4*)((const float*)base + off + 4); } }
#pragma unroll
            for (int m = 0; m < 4; ++m) { const int row = u.pm * 256 + ai * 128 + wr * 64 + m * 16 + fr; float sq = 0.f;
#pragma unroll
                for (int bj = 0; bj < 2; ++bj) { const size_t off = (size_t)row * 1024 + u.pn * 256 + bj * 128 + wc * 32 + 8 * fq;
                    const f32x4 v0 = acc[ai][bj][m][0] + bv[m][bj][0], v1 = acc[ai][bj][m][1] + bv[m][bj][1];
                    if (WRITE_F32) { *(f32x4*)(out + off) = v0; *(f32x4*)(out + off + 4) = v1; }
                    if (hb) { u32x4 w; w.x = pk2(v0[0], v0[1]); w.y = pk2(v0[2], v0[3]); w.z = pk2(v1[0], v1[1]); w.w = pk2(v1[2], v1[3]); *(u32x4*)(hb + off) = w; }
                    sq += (v0[0] * v0[0] + v0[1] * v0[1]) + (v0[2] * v0[2] + v0[3] * v0[3]) + (v1[0] * v1[0] + v1[1] * v1[1]) + (v1[2] * v1[2] + v1[3] * v1[3]); }
                sq += __shfl_xor(sq, 16); sq += __shfl_xor(sq, 32);
                if (fq == 0) __hip_atomic_fetch_add(ss + row, sq, __ATOMIC_RELAXED, __HIP_MEMORY_SCOPE_AGENT); }
            asm volatile("" ::: "memory");
        }
    }
};
typedef EpiRes<true, false> EpiResMix;
typedef EpiRes<true, true> EpiResFfn;
struct EpiUpConv {
    static constexpr bool PERM = true, AFTER_DRAIN = false;
    const float* ss; bf16_t* act; const float* cw; const float* cb; float* ghead; float* gtail;
    __device__ __forceinline__ void operator()(AccRef acc, const pg8::Unit& u, int wr, int wc, int fr, int fq) const {
        asm volatile("" : "+v"(fr), "+v"(fq));
        const int ch0 = u.pn * 128 + wc * 32 + 8 * fq, tok0 = u.pm * 256 + wr * 128 + fr * 8, grp = tok0 >> 7;
        const bool seq0 = (tok0 & (SEQ - 1)) == 0, head = (fr == 0) && !seq0;
        const f32x4 rsa = *(const f32x4*)(ss + tok0), rsb = *(const f32x4*)(ss + tok0 + 4);
        float rs[8];
#pragma unroll
        for (int k = 0; k < 4; ++k) { rs[k] = rstd_of(rsa[k]); rs[4 + k] = rstd_of(rsb[k]); }
        unsigned ylo[8][2];
#pragma unroll
        for (int n = 0; n < 2; ++n) {
            const int ch = ch0 + 4 * n;
            const f32x4 w0 = *(const f32x4*)(cw + ch), w1 = *(const f32x4*)(cw + DFF + ch), w2 = *(const f32x4*)(cw + 2 * DFF + ch), bb = *(const f32x4*)(cb + ch);
            const f32x4 g6 = acc[1][1][2][n] * rs[6], g7 = acc[1][1][3][n] * rs[7];
            f32x4 gm2, gm1;
#pragma unroll
            for (int j = 0; j < 4; ++j) { gm2[j] = __shfl_up(g6[j], 1); gm1[j] = __shfl_up(g7[j], 1); }
            if (seq0) { gm2 = (f32x4){0.f, 0.f, 0.f, 0.f}; gm1 = gm2; }
            if (fr == 15) { *(f32x4*)(gtail + ((size_t)grp * 2 + 0) * DFF + ch) = g6; *(f32x4*)(gtail + ((size_t)grp * 2 + 1) * DFF + ch) = g7; }
#pragma unroll
            for (int k = 0; k < 8; ++k) {
                const f32x4 gk = acc[k >> 2][1][k & 3][n] * rs[k], ak = acc[k >> 2][0][k & 3][n] * rs[k];
                const f32x4 part = (k == 1) ? (w1 * gm1 + w2 * gk + bb) : (w2 * gk + bb);
                if (k < 2 && head) { *(f32x4*)(ghead + ((size_t)grp * 4 + k) * DFF + ch) = part; *(f32x4*)(ghead + ((size_t)grp * 4 + 2 + k) * DFF + ch) = ak; }
                const f32x4 gc = (k == 1) ? (part + w0 * gm2) : (part + w0 * gm2 + w1 * gm1);
                const unsigned p0 = pk2(gc[0] * sigm(gc[0]) * ak[0], gc[1] * sigm(gc[1]) * ak[1]), p1 = pk2(gc[2] * sigm(gc[2]) * ak[2], gc[3] * sigm(gc[3]) * ak[3]);
                if (n == 0) { ylo[k][0] = p0; ylo[k][1] = p1; }
                else { u32x4 w; w.x = ylo[k][0]; w.y = ylo[k][1]; w.z = p0; w.w = p1; *(u32x4*)(act + (size_t)(tok0 + k) * DFF + ch0) = w; }
                gm2 = gm1; gm1 = gk;
            }
        }
    }
};
struct GroupOrder {
    int L0, L1;
    __device__ __forceinline__ bool next(int i, pg8::Unit& u) const { const int L = i == 0 ? L0 : (i == 1 ? L1 : -1); if (L < 0) return false; u.pm = L; u.pn = L >> 3; return true; }
    __device__ __forceinline__ void a_ready(const pg8::Unit&) const {}
    __device__ __forceinline__ void done(const pg8::Unit&) const {}
};

__device__ __forceinline__ void tr_item(const float* __restrict__ W, int K, int N, bf16_t* __restrict__ dst, const float* __restrict__ gk, int cs_from, int mode, int row_off,
                                        LAS float* scr, int item, int lane) {
    const int nblk = N / 64, kb = item / nblk, nb = item - kb * nblk, k0 = 32 * kb, n0 = 64 * nb;
    const int lk = lane >> 4, ln = (lane & 15) * 4;
    f32x4 v[8];
#pragma unroll
    for (int i = 0; i < 8; ++i) v[i] = *(const f32x4*)(W + (size_t)(k0 + 4 * i + lk) * N + n0 + ln);
    if (gk) {
#pragma unroll
        for (int i = 0; i < 8; ++i) v[i] = v[i] * gk[k0 + 4 * i + lk];
    }
#pragma unroll
    for (int i = 0; i < 8; ++i) { LAS float* s = scr + (4 * i + lk) * 65 + ln; s[0] = v[i][0]; s[1] = v[i][1]; s[2] = v[i][2]; s[3] = v[i][3]; }
    asm volatile("s_waitcnt lgkmcnt(0)" ::: "memory");
    const float csc = (n0 >= cs_from) ? C2 : 1.f;
    int drow0;
    if (mode == 1) { drow0 = (n0 < DFF) ? 256 * (n0 >> 7) + (n0 & 127) : 256 * ((n0 - DFF) >> 7) + 128 + ((n0 - DFF) & 127); } else drow0 = row_off + n0;
    const int c = lane & 3;
#pragma unroll
    for (int j = 0; j < 4; ++j) { const int n = (lane >> 2) + 16 * j; const LAS float* s = scr + (8 * c) * 65 + n;
        u32x4 o; o.x = pk2(s[0] * csc, s[65] * csc); o.y = pk2(s[130] * csc, s[195] * csc); o.z = pk2(s[260] * csc, s[325] * csc); o.w = pk2(s[390] * csc, s[455] * csc);
        *(u32x4*)(dst + (size_t)(drow0 + n) * K + k0 + 8 * c) = o; }
    asm volatile("s_waitcnt lgkmcnt(0)" ::: "memory");
}

__device__ __forceinline__ void s5_tables(const float* a_re, const float* a_im, const float* log_dt, const float* b_re, const float* b_im, const float* c_re, const float* c_im, const float* s5d,
                                          bf16_t* Bt1, bf16_t* Bt3, LAS float* L, int g, int part, int tid) {
    LAS float* Are = L; LAS float* Aim = L + 1088; LAS float* Bre = L + 2176; LAS float* Bim = L + 3200; LAS float* Cre = L + 4224; LAS float* Cim = L + 5248; LAS float* Kt = L + 6272;
    if (tid < 64) {
        const int p = tid; const float dt = fexp(log_dt[g]); const float lr = fminf(a_re[g * 64 + p], -1e-4f), li = a_im[g * 64 + p];
        for (int k = 0; k <= 16; ++k) { const float mag = fexp(lr * dt * (float)k); float rev = li * dt * (float)k * INV2PI; rev -= rintf(rev);
            Are[k * 64 + p] = mag * __builtin_amdgcn_cosf(rev); Aim[k * 64 + p] = mag * __builtin_amdgcn_sinf(rev); }
        const float abr = Are[64 + p], abi = Aim[64 + p], den = lr * lr + li * li;
        const float zr = ((abr - 1.f) * lr + abi * li) / den, zi = (abi * lr - (abr - 1.f) * li) / den;
        for (int j = 0; j < 16; ++j) { const float br = b_re[(g * 64 + p) * 16 + j], bi = b_im[(g * 64 + p) * 16 + j]; Bre[p * 16 + j] = zr * br - zi * bi; Bim[p * 16 + j] = zr * bi + zi * br; }
    }
    for (int e = tid; e < 1024; e += NTHREADS) { Cre[e] = c_re[g * 1024 + e]; Cim[e] = c_im[g * 1024 + e]; }
    __syncthreads();
    if (part == 0) {
    for (int q = 0; q < 8; ++q) { const int e = tid + NTHREADS * q, k = e >> 8, i = (e >> 4) & 15, j = e & 15; float acc = 0.f;
        for (int p = 0; p < 64; ++p) { const float ar = Are[k * 64 + p], ai = Aim[k * 64 + p], br = Bre[p * 16 + j], bi = Bim[p * 16 + j];
            acc += Cre[i * 64 + p] * (ar * br - ai * bi) - Cim[i * 64 + p] * (ar * bi + ai * br); }
        Kt[e] = acc; }
    __syncthreads();
    for (int idx = tid; idx < 256 * 256; idx += NTHREADS) { const int n = idx >> 8, k = idx & 255, s = n >> 4, i = n & 15, r = k >> 4, j = k & 15;
        float v = (s >= r) ? Kt[((s - r) * 16 + i) * 16 + j] : 0.f; if (s == r && i == j) v += s5d[g * 16 + i];
        Bt3[(size_t)(g * 256 + n) * 384 + k] = f2bf(v); }
    } else {
    for (int idx = tid; idx < 256 * 128; idx += NTHREADS) { const int n = idx >> 7, k = 256 + (idx & 127), s = n >> 4, i = n & 15; float v;
        if (k < 320) { const int p = k - 256; v = Cre[i * 64 + p] * Are[(s + 1) * 64 + p] - Cim[i * 64 + p] * Aim[(s + 1) * 64 + p]; }
        else { const int p = k - 320; v = -(Cre[i * 64 + p] * Aim[(s + 1) * 64 + p] + Cim[i * 64 + p] * Are[(s + 1) * 64 + p]); }
        Bt3[(size_t)(g * 256 + n) * 384 + k] = f2bf(v); }
    for (int idx = tid; idx < 65536; idx += NTHREADS) { const int n = idx >> 8, k = idx & 255, r = k >> 4, j = k & 15; float v = 0.f;
        if (n < 64) { const int p = n; v = Are[(15 - r) * 64 + p] * Bre[p * 16 + j] - Aim[(15 - r) * 64 + p] * Bim[p * 16 + j]; }
        else if (n < 128) { const int p = n - 64; v = Are[(15 - r) * 64 + p] * Bim[p * 16 + j] + Aim[(15 - r) * 64 + p] * Bre[p * 16 + j]; }
        Bt1[(size_t)(g * 256 + n) * 256 + k] = f2bf(v); }
    }
    __syncthreads();
}

__device__ __forceinline__ void s5_scan_item(const float* a_re, const float* a_im, const float* log_dt, const float* __restrict__ sloc, bf16_t* __restrict__ A3, int item, int lane) {
    const int g = item >> 3, b = item & 7, p = lane;
    const float dt = fexp(log_dt[g]); const float lr = fminf(a_re[g * 64 + p], -1e-4f), li = a_im[g * 64 + p];
    const float mag = fexp(lr * dt * 16.f); float rev = li * dt * 16.f * INV2PI; rev -= rintf(rev);
    const float ar = mag * __builtin_amdgcn_cosf(rev), ai = mag * __builtin_amdgcn_sinf(rev);
    float hr = 0.f, hi = 0.f; const size_t row0 = (size_t)g * 2048 + b * 256;
    float sr[16], si[16], nr[16], ni[16];
#define SCAN_LOAD(dr, di, c0) _Pragma("unroll") for (int q = 0; q < 16; ++q) { dr[q] = sloc[(row0 + (c0) + q) * 128 + p]; di[q] = sloc[(row0 + (c0) + q) * 128 + 64 + p]; }
#define SCAN_STEP(xr, xi, c0) _Pragma("unroll") for (int q = 0; q < 16; ++q) { bf16_t* a = A3 + (row0 + (c0) + q) * 384 + 256 + p; a[0] = f2bf(hr); a[64] = f2bf(hi); \
            const float t = ar * hr - ai * hi + xr[q]; hi = ar * hi + ai * hr + xi[q]; hr = t; }
    SCAN_LOAD(sr, si, 0)
#pragma unroll 1
    for (int c0 = 0; c0 < 256; c0 += 32) {
        SCAN_LOAD(nr, ni, c0 + 16)
        SCAN_STEP(sr, si, c0)
        if (c0 + 32 < 256) { SCAN_LOAD(sr, si, c0 + 32) }
        SCAN_STEP(nr, ni, c0 + 16)
    }
#undef SCAN_LOAD
#undef SCAN_STEP
}

__device__ __forceinline__ void convfix_panel(bf16_t* __restrict__ act, const float* __restrict__ ghead, const float* __restrict__ gtail, const float* __restrict__ cw, int pm, int tid) {
    for (int idx = tid; idx < 2 * 352; idx += NTHREADS) {
        const int grp = 2 * pm + idx / 352, ch = (idx % 352) * 8;
        if ((grp & 31) == 0) continue;
        unsigned o0[4], o1[4];
#pragma unroll
        for (int hh = 0; hh < 2; ++hh) { const int c = ch + 4 * hh;
            const f32x4 P0 = *(const f32x4*)(ghead + ((size_t)grp * 4 + 0) * DFF + c), P1 = *(const f32x4*)(ghead + ((size_t)grp * 4 + 1) * DFF + c);
            const f32x4 a0 = *(const f32x4*)(ghead + ((size_t)grp * 4 + 2) * DFF + c), a1 = *(const f32x4*)(ghead + ((size_t)grp * 4 + 3) * DFF + c);
            const f32x4 T6 = *(const f32x4*)(gtail + ((size_t)(grp - 1) * 2 + 0) * DFF + c), T7 = *(const f32x4*)(gtail + ((size_t)(grp - 1) * 2 + 1) * DFF + c);
            const f32x4 w0 = *(const f32x4*)(cw + c), w1 = *(const f32x4*)(cw + DFF + c);
            const f32x4 c0 = P0 + w0 * T6 + w1 * T7, c1 = P1 + w0 * T7;
            o0[2 * hh] = pk2(c0[0] * sigm(c0[0]) * a0[0], c0[1] * sigm(c0[1]) * a0[1]); o0[2 * hh + 1] = pk2(c0[2] * sigm(c0[2]) * a0[2], c0[3] * sigm(c0[3]) * a0[3]);
            o1[2 * hh] = pk2(c1[0] * sigm(c1[0]) * a1[0], c1[1] * sigm(c1[1]) * a1[1]); o1[2 * hh + 1] = pk2(c1[2] * sigm(c1[2]) * a1[2], c1[3] * sigm(c1[3]) * a1[3]); }
        u32x4 w; w.x = o0[0]; w.y = o0[1]; w.z = o0[2]; w.w = o0[3]; *(u32x4*)(act + (size_t)(grp * 128) * DFF + ch) = w;
        w.x = o1[0]; w.y = o1[1]; w.z = o1[2]; w.w = o1[3]; *(u32x4*)(act + (size_t)(grp * 128 + 1) * DFF + ch) = w;
    }
}

__device__ __forceinline__ void fgate_phase(const bf16_t* __restrict__ h, const float* __restrict__ ss, const float* __restrict__ wf, const float* __restrict__ gkv, const float* __restrict__ bfg,
                                            float* __restrict__ logf, LAS float* L, int tid, int wid, int lane) {
#pragma unroll 4
    for (int rec = tid; rec < 1024; rec += NTHREADS) { const int k = 256 * (rec >> 8) + 4 * (rec & 63) + ((rec >> 6) & 3); const float gk = gkv[k];
        const f32x4 a = *(const f32x4*)(wf + k * 12), b = *(const f32x4*)(wf + k * 12 + 4), c = *(const f32x4*)(wf + k * 12 + 8);
        LAS f32x4* d = (LAS f32x4*)(L + rec * 12); d[0] = a * gk; d[1] = b * gk; d[2] = c * gk; }
    __syncthreads();
    const LAS f32x4* L4 = (const LAS f32x4*)L;
    typedef unsigned u32x2_t __attribute__((ext_vector_type(2)));
    const int rstep = gridDim.x * NWAVES * 2; int r0 = (blockIdx.x * NWAVES + wid) * 2;
    u32x2_t hw[2][4], hn[2][4];
    { const int rc = r0 < NTOK ? r0 : 0;
#pragma unroll
      for (int r = 0; r < 2; ++r)
#pragma unroll
          for (int i = 0; i < 4; ++i) hw[r][i] = *(const u32x2_t*)(h + (size_t)(rc + r) * 1024 + 256 * i + 4 * lane); }
#pragma unroll 1
    for (; r0 < NTOK; r0 += rstep) {
        { const int rn = r0 + rstep < NTOK ? r0 + rstep : r0;
#pragma unroll
          for (int r = 0; r < 2; ++r)
#pragma unroll
              for (int i = 0; i < 4; ++i) hn[r][i] = *(const u32x2_t*)(h + (size_t)(rn + r) * 1024 + 256 * i + 4 * lane); }
        f32x4 hv[2][4];
#pragma unroll
        for (int r = 0; r < 2; ++r)
#pragma unroll
            for (int i = 0; i < 4; ++i) hv[r][i] = (f32x4){bf_lo(hw[r][i].x), bf_hi(hw[r][i].x), bf_lo(hw[r][i].y), bf_hi(hw[r][i].y)};
        float acc[2][12];
#pragma unroll
        for (int r = 0; r < 2; ++r)
#pragma unroll
            for (int q = 0; q < 12; ++q) acc[r][q] = 0.f;
#pragma unroll
        for (int i = 0; i < 4; ++i)
#pragma unroll
            for (int e = 0; e < 4; ++e) { const int rec = (i * 4 + e) * 64 + lane; const f32x4 wa = L4[rec * 3], wb = L4[rec * 3 + 1], wc4 = L4[rec * 3 + 2];
#pragma unroll
                for (int r = 0; r < 2; ++r) { const float x = hv[r][i][e];
                    acc[r][0] += x * wa[0]; acc[r][1] += x * wa[1]; acc[r][2] += x * wa[2]; acc[r][3] += x * wa[3];
                    acc[r][4] += x * wb[0]; acc[r][5] += x * wb[1]; acc[r][6] += x * wb[2]; acc[r][7] += x * wb[3];
                    acc[r][8] += x * wc4[0]; acc[r][9] += x * wc4[1]; acc[r][10] += x * wc4[2]; acc[r][11] += x * wc4[3]; }
                if ((e & 1) == 1) __builtin_amdgcn_sched_barrier(0); }
        float z = 0.f;
#pragma unroll
        for (int r = 0; r < 2; ++r)
#pragma unroll
            for (int q = 0; q < 12; ++q) { const float v = wave_sum(acc[r][q]); if (lane == r * 12 + q) z = v; }
        if (lane < 24) { const int r = lane / 12, q = lane - r * 12, row = r0 + r;
            z = z * rstd_of(ss[row]) + bfg[q];
            const float lf = fminf(z, 0.f) - __logf(1.f + fexp(-fabsf(z)));
            logf[(size_t)((row >> 12) * NHEAD + q) * SEQ + (row & (SEQ - 1))] = lf; }
#pragma unroll
        for (int r = 0; r < 2; ++r)
#pragma unroll
            for (int i = 0; i < 4; ++i) hw[r][i] = hn[r][i];
    }
    __syncthreads();
}

__device__ __forceinline__ void build_btab(const float* __restrict__ lf, LAS float* btab, LAS float* wsum, int tid, int wid, int lane) {
    __syncthreads();
    const f32x4 a = *(const f32x4*)(lf + 8 * tid), b = *(const f32x4*)(lf + 8 * tid + 4);
    float p[8]; p[0] = a[0]; p[1] = p[0] + a[1]; p[2] = p[1] + a[2]; p[3] = p[2] + a[3]; p[4] = p[3] + b[0]; p[5] = p[4] + b[1]; p[6] = p[5] + b[2]; p[7] = p[6] + b[3];
    float x = p[7];
#pragma unroll
    for (int o = 1; o < 64; o <<= 1) { const float n = __shfl_up(x, o); if (lane >= o) x += n; }
    if (lane == 63) wsum[wid] = x;
    __syncthreads();
    float off = x - p[7];
    for (int w = 0; w < wid; ++w) off += wsum[w];
    f32x4 o0, o1;
    o0[0] = -(off + p[0]) * LOG2E; o0[1] = -(off + p[1]) * LOG2E; o0[2] = -(off + p[2]) * LOG2E; o0[3] = -(off + p[3]) * LOG2E;
    o1[0] = -(off + p[4]) * LOG2E; o1[1] = -(off + p[5]) * LOG2E; o1[2] = -(off + p[6]) * LOG2E; o1[3] = -(off + p[7]) * LOG2E;
    *(LAS f32x4*)(btab + 8 * tid) = o0; *(LAS f32x4*)(btab + 8 * tid + 4) = o1;
    __syncthreads();
}

__device__ __forceinline__ void mem_attn_phase(const bf16_t* proj, const bf16_t* memkv, bf16_t* tokmix, char* lds, int n_light, int lu) {
    const int NU = NB * 4 * 16, G = gridDim.x, bx = blockIdx.x;
    int u0, u1, ust;
    if (n_light > 0 && n_light < G && n_light * lu < NU) { const int nl = n_light * lu, per = (NU - nl + (G - n_light) - 1) / (G - n_light);
        if (bx < n_light) { u0 = bx * lu; u1 = u0 + lu; } else { u0 = nl + (bx - n_light) * per; u1 = u0 + per < NU ? u0 + per : NU; } ust = 1; }
    else { u0 = bx; u1 = NU; ust = G; }
    for (int ui = u0; ui < u1; ui += ust) {
        const int b = ui >> 6, h = (ui >> 4) & 3, qb = ui & 15;
        const size_t qoff = (size_t)(b * SEQ + qb * 256) * 1024 + DTOK + h * 64;
        const bf16_t* K = memkv + (size_t)(b * MEMT) * 512 + h * 64;
        attn_body::attn_unit<8, false, false, 1024, 512>((const abf16*)(proj + qoff), (const abf16*)K, (const abf16*)(K + 256), (abf16*)(tokmix + qoff), 4, (attn_body::lds_f4p)nullptr, lds);
    }
}
__device__ __forceinline__ void fox_attn_phase(const bf16_t* proj, const bf16_t* kv, bf16_t* tokmix, const float* logf, const unsigned* kmax, unsigned* ctr, char* lds, LAS unsigned char* ldsl, int tid, int wid, int lane) {
    int last_bh = -1;
    LAS float* btab = (LAS float*)(ldsl + LDS_BTAB); LAS float* wsum = (LAS float*)(ldsl + LDS_WSUM); volatile LAS unsigned* nxt = (volatile LAS unsigned*)(ldsl + LDS_WSUM + 128);
#pragma unroll 1
    for (;;) {
        __syncthreads();
        if (tid == 0) nxt[0] = __hip_atomic_fetch_add(ctr, 1u, __ATOMIC_RELAXED, __HIP_MEMORY_SCOPE_AGENT);
        __syncthreads();
        const int ui = (int)nxt[0];
        if (ui >= NB * NHEAD * 16) break;
        const int qb = 15 - ui / (NB * NHEAD), bh = ui % (NB * NHEAD), b = bh / NHEAD, h = bh - b * NHEAD;
        if (bh != last_bh) { build_btab(logf + (size_t)bh * SEQ, btab, wsum, tid, wid, lane); last_bh = bh; }
        const bf16_t* K = kv + (size_t)(b * SEQ) * 1536 + h * 64;
        const size_t qoff = (size_t)(b * SEQ + qb * 256) * 1024 + h * 64;
        const float kmv = 1.01f * sqrtf(__uint_as_float(kmax[bh * 2]) + __uint_as_float(kmax[bh * 2 + 1]));
        attn_body::attn_unit<8, true, true, 1024, 1536, true, true>((const abf16*)(proj + qoff), (const abf16*)K, (const abf16*)(K + DTOK), (abf16*)(tokmix + qoff), 4 * qb + 4, (attn_body::lds_f4p)btab, lds, kmv, (LAS float*)(ldsl + LDS_WSUM + 64));
    }
}

#define XB_TMO      128
#define XB_XCNT(j)  (256  + 64 * (j))
#define XB_XSUB(j)  (1280 + 64 * (j))
#define XB_XGEN(j)  (2304 + 64 * (j))
#define XB_TOP      3328
#define XB_TOPGEN   3392
#define XCD_BAR_WORDS 3456
#define XB_SPIN_CAP (1u << 18)

__device__ __forceinline__ unsigned xb_ld(unsigned* p)              { return __hip_atomic_load(p, __ATOMIC_RELAXED, __HIP_MEMORY_SCOPE_AGENT); }
__device__ __forceinline__ unsigned xb_add(unsigned* p, unsigned v) { return __hip_atomic_fetch_add(p, v, __ATOMIC_RELAXED, __HIP_MEMORY_SCOPE_AGENT); }
__device__ __forceinline__ unsigned xb_xcc_id() { return (unsigned)__builtin_amdgcn_s_getreg((3 << 11) | 20) & 0xFu; }
#define XB_SPIN(cond, bar) do { unsigned _sp = 0; while (cond) { __builtin_amdgcn_s_sleep(1); \
    if ((++_sp & 255u) == 0u) { if (xb_ld(&(bar)[XB_TMO])) break; if (_sp > XB_SPIN_CAP) { atomicAdd(&(bar)[XB_TMO], 1u); break; } } } } while (0)

struct XcdBarrier {
    unsigned* bar; unsigned x;
    volatile LAS unsigned* st;
};

__device__ __forceinline__ XcdBarrier xcd_barrier_post(unsigned* bar, volatile LAS unsigned* st) {
    XcdBarrier b; b.bar = bar; b.x = xb_xcc_id(); b.st = st;
    if (threadIdx.x == 0) (void)xb_add(&bar[XB_XCNT(b.x)], 1u);
    return b;
}
__device__ __forceinline__ void xcd_barrier_complete(unsigned* bar, unsigned x, unsigned& nloc, unsigned& nx) {
    const unsigned G = gridDim.x * gridDim.y * gridDim.z;
    unsigned sum, cnt, mine, sp = 0u;
    for (;;) {
        sum = 0u; cnt = 0u; mine = 0u;
#pragma unroll
        for (unsigned j = 0; j < 16; ++j) { const unsigned c = xb_ld(&bar[XB_XCNT(j)]); sum += c; cnt += (c > 0u) ? 1u : 0u; mine = (j == x) ? c : mine; }
        if (sum == G) break;
        __builtin_amdgcn_s_sleep(1);
        if ((++sp & 255u) == 0u) { if (xb_ld(&bar[XB_TMO])) break; if (sp > XB_SPIN_CAP) { atomicAdd(&bar[XB_TMO], 1u); break; } }
    }
    nloc = mine > 0u ? mine : 1u; nx = cnt > 0u ? cnt : 1u;
}

__device__ __forceinline__ void xcd_barrier(const XcdBarrier& b) {
    asm volatile("s_waitcnt vmcnt(0)" ::: "memory");
    __syncthreads();
    if (threadIdx.x == 0) {
        unsigned* bar = b.bar;
        __builtin_amdgcn_s_waitcnt(0);
        unsigned nloc = b.st[0], nx = b.st[1];
        if (nloc == 0u) { xcd_barrier_complete(bar, b.x, nloc, nx); b.st[0] = nloc; b.st[1] = nx; }
        const unsigned old = xb_add(&bar[XB_XSUB(b.x)], 1u);
        const unsigned gen = old / nloc;
        if (old + 1u == (gen + 1u) * nloc) {
            __builtin_amdgcn_fence(__ATOMIC_RELEASE, "agent");
            asm volatile("s_waitcnt vmcnt(0)" ::: "memory");
            const unsigned og = xb_add(&bar[XB_TOP], 1u);
            const unsigned tg = og / nx;
            if (og + 1u == (tg + 1u) * nx) xb_add(&bar[XB_TOPGEN], 1u);
            else XB_SPIN(xb_ld(&bar[XB_TOPGEN]) == tg, bar);
            __builtin_amdgcn_fence(__ATOMIC_ACQUIRE, "agent");
            xb_add(&bar[XB_XGEN(b.x)], 1u);
            asm volatile("s_waitcnt vmcnt(0)" ::: "memory");
        } else {
            XB_SPIN(xb_ld(&bar[XB_XGEN(b.x)]) == gen, bar);
            __builtin_amdgcn_fence(__ATOMIC_ACQUIRE, "agent");
            asm volatile("s_waitcnt vmcnt(0)" ::: "memory");
        }
    }
    __syncthreads();
}

struct Args { const float* in[26]; float* out; unsigned char* ws; };
#define GEMM_CALL(EpiT, OrdT, g, S, E) pg8::gemm_phase<EpiT, OrdT, true, true>(ldsl, g, S, E)

__global__ void __launch_bounds__(NTHREADS, 2) fwd_megakernel(Args a) {
    extern __shared__ __attribute__((aligned(16))) unsigned char lds[];
    cg::grid_group grid = cg::this_grid();
    LAS unsigned char* ldsl = (LAS unsigned char*)lds;
#define TIDS() int tid_o = threadIdx.x; asm volatile("" : "+v"(tid_o)); const int tid = tid_o, lane = tid & 63, wid = __builtin_amdgcn_readfirstlane(tid >> 6); (void)lane; (void)wid
    const int G = gridDim.x, bx = blockIdx.x;
    unsigned* barw = (unsigned*)(a.ws + WS_BAR); volatile LAS unsigned* bst = (volatile LAS unsigned*)(ldsl + LDS_BYTES - 64);
    if (threadIdx.x < 2) bst[threadIdx.x] = 0u;
    unsigned char* ws = a.ws;
    const float* x = a.in[0]; float* out = a.out;
    float* ss = (float*)(ws + WS_SS); float* logf = (float*)(ws + WS_LOGF); unsigned* kmaxp = (unsigned*)(ws + WS_KMAX);
    bf16_t* hb = (bf16_t*)(ws + WS_HB);
    bf16_t* WIN0 = (bf16_t*)(ws + WS_WIN0); bf16_t* WGLU = (bf16_t*)(ws + WS_WGLU); bf16_t* WKVQ = (bf16_t*)(ws + WS_WKVQ);
    bf16_t* BT1 = (bf16_t*)(ws + WS_BT1); bf16_t* BT3 = (bf16_t*)(ws + WS_BT3); bf16_t* memn = (bf16_t*)(ws + WS_MEMN);
    bf16_t* A3 = (bf16_t*)(ws + WS_A3); float* sloc = (float*)(ws + WS_SLOC); bf16_t* gb = (bf16_t*)(ws + WS_GB); bf16_t* tokmix = (bf16_t*)(ws + WS_TOKMIX);
    bf16_t* abuf = (bf16_t*)(ws + WS_ABUF); float* ghead = (float*)(ws + WS_GBUF); float* gtail = (float*)(ws + WS_GBUF + 16 * MiB); bf16_t* kvb = (bf16_t*)(ws + WS_KV);
    bf16_t* proj0 = (bf16_t*)(ws + WS_PROJ0); bf16_t* proj1 = (bf16_t*)(ws + WS_PROJ1);

    constexpr int I_SQ = 16 * 32, I_UP = 16 * 176, I_DN = 44 * 32, I_GLU = 12 * 24, I_KV = 16 * 48, I_MKV = 16 * 16, BIG = 1 << 30, NTB = 2 * NGRP;
    {
        TIDS();
        if (bx == 0) for (int i = tid; i < XCD_BAR_WORDS; i += NTHREADS) barw[i] = 0u;
        if (bx == 0 && tid < NB * NHEAD * 2) kmaxp[tid] = 0u;
        if (bx == 0 && tid == 0) kmaxp[1024] = 0u;
        const bool split = G > NTB;
        for (int tb = bx; tb < NTB; tb += G) s5_tables(a.in[7], a.in[8], a.in[9], a.in[10], a.in[11], a.in[12], a.in[13], a.in[14], BT1, BT3, (LAS float*)ldsl, tb >> 1, tb & 1, tid);
        if (!split || bx >= NTB) {
            LAS float* scr = (LAS float*)(ldsl + wid * 16384);
            const int gw = (split ? bx - NTB : bx) * NWAVES + wid, NGW = (split ? G - NTB : G) * NWAVES;
            for (int it = gw; it < I_SQ + 2 * I_MKV; it += NGW) {
                int r = it;
                if (r < I_SQ) { tr_item(a.in[3], 1024, 1024, WIN0, a.in[2], DTOK, 0, 0, scr, r, lane); continue; } r -= I_SQ;
                if (r < I_MKV) { tr_item(a.in[6], 1024, 512, (bf16_t*)(ws + WS_WMKV0), nullptr, BIG, 0, 0, scr, r, lane); continue; } r -= I_MKV;
                tr_item(a.in[6] + 1024 * 512, 1024, 512, (bf16_t*)(ws + WS_WMKV1), nullptr, BIG, 0, 0, scr, r, lane);
            }
#pragma unroll 1
            for (int m = gw * 4; m < NTOK; m += NGW * 4) {
                const f32x4* xr = (const f32x4*)(x + (size_t)m * 1024) + lane; f32x4 v[16]; float s4[4];
#pragma unroll
                for (int j = 0; j < 16; ++j) v[j] = xr[64 * j];
#pragma unroll
                for (int r = 0; r < 4; ++r) { float s = 0.f;
#pragma unroll
                    for (int j = 0; j < 4; ++j) { const f32x4 t = v[4 * r + j]; s += (t[0] * t[0] + t[1] * t[1]) + (t[2] * t[2] + t[3] * t[3]); }
                    s4[r] = wave_sum(s); }
                if (lane == 0) { ss[m] = s4[0]; ss[m + 1] = s4[1]; ss[m + 2] = s4[2]; ss[m + 3] = s4[3]; }
                unsigned long long* o8 = (unsigned long long*)(hb + (size_t)m * 1024) + lane;
#pragma unroll
                for (int j = 0; j < 16; ++j) o8[64 * j] = (unsigned long long)pk2(v[j][0], v[j][1]) | ((unsigned long long)pk2(v[j][2], v[j][3]) << 32);
            }
            for (int m = gw; m < NB * MEMT; m += NGW) {
                const f32x4* xr = (const f32x4*)(a.in[1] + (size_t)m * 1024) + lane; const f32x4* gr = (const f32x4*)a.in[5] + lane; f32x4 v[4]; float s = 0.f;
#pragma unroll
                for (int j = 0; j < 4; ++j) { v[j] = xr[64 * j]; s += (v[j][0] * v[j][0] + v[j][1] * v[j][1]) + (v[j][2] * v[j][2] + v[j][3] * v[j][3]); }
                const float rs = rstd_of(wave_sum(s));
                unsigned long long* o8 = (unsigned long long*)(memn + (size_t)m * 1024) + lane;
#pragma unroll
                for (int j = 0; j < 4; ++j) { const f32x4 gg = gr[64 * j]; o8[64 * j] = (unsigned long long)pk2(v[j][0] * rs * gg[0], v[j][1] * rs * gg[1]) | ((unsigned long long)pk2(v[j][2] * rs * gg[2], v[j][3] * rs * gg[3]) << 32); }
            }
            for (int i = gw * 64 + lane; i < 4 * NTOK; i += NGW * 64) ss[NTOK + i] = 0.f;
        }
    }
    grid.sync();
    const XcdBarrier xbar = xcd_barrier_post(barw, bst);
#define SEAM() xcd_barrier(xbar)

    {
        pg8::Gemm g{hb, WIN0, NTOK, 1024, 1024, 1024, 1024}; pg8::StaticOrder S; S.init(NTOK, 1024, G, bx);
        EpiIn0 E{ss, A3, proj0}; GEMM_CALL(EpiIn0, pg8::StaticOrder, g, S, E);
    }
    SEAM();
    {
        const int s5k0 = bx >> 3, s5k1 = 32 + (bx >> 3);
        const int s5L0 = (G == 256) ? ((bx & 7) * 6 + (s5k0 >> 3)) * 8 + (s5k0 & 7) : (bx < NGRP * 8 ? bx : -1);
        const int s5L1 = (G == 256) ? (s5k1 < 48 ? ((bx & 7) * 6 + (s5k1 >> 3)) * 8 + (s5k1 & 7) : -1) : (G + bx < NGRP * 8 ? G + bx : -1);
        GroupOrder S{s5L0, s5L1};
        { pg8::Gemm g{A3, BT1, NGRP * 2048, NGRP * 256, 256, 384, 256}; EpiS1 E{sloc}; GEMM_CALL(EpiS1, GroupOrder, g, S, E); }
        asm volatile("s_waitcnt vmcnt(0)" ::: "memory"); __syncthreads(); __builtin_amdgcn_fence(__ATOMIC_ACQUIRE, "agent");
        {
            TIDS();
            if (wid < 2) { const int item = wid ? s5L1 : s5L0; if (item >= 0) s5_scan_item(a.in[7], a.in[8], a.in[9], sloc, A3, item, lane); }
        else {
            LAS float* scr = (LAS float*)(ldsl + wid * 16384);
            constexpr int NLATE = 3 * I_SQ + 2 * I_UP + 2 * I_DN + I_GLU + I_KV;
            const int n2 = (NGRP * NB > G) ? ((NGRP * NB - G < G) ? NGRP * NB - G : G) : 0;
            const int nslots = 6 * n2 + 12 * (G - n2), slot0 = (bx < n2) ? 6 * bx + (wid - 2) : 6 * n2 + 12 * (bx - n2) + (wid - 2), nmine = (bx < n2) ? 1 : 2;
            for (int sl = 0; sl < nmine; ++sl)
            for (int it = slot0 + 6 * sl; it < NLATE; it += nslots) {
                int r = it;
                if (r < I_GLU) { tr_item(a.in[15], DTOK, DTOK, WGLU, nullptr, BIG, 0, 0, scr, r, lane); continue; } r -= I_GLU;
                if (r < I_SQ) { tr_item(a.in[4], 1024, 1024, (bf16_t*)(ws + WS_WOUT0), nullptr, BIG, 0, 0, scr, r, lane); continue; } r -= I_SQ;
                if (r < I_UP) { tr_item(a.in[21], 1024, 2 * DFF, (bf16_t*)(ws + WS_WUP0), a.in[20], BIG, 1, 0, scr, r, lane); continue; } r -= I_UP;
                if (r < I_DN) { tr_item(a.in[24], DFF, 1024, (bf16_t*)(ws + WS_WDN0), nullptr, BIG, 0, 0, scr, r, lane); continue; } r -= I_DN;
                if (r < I_KV) { tr_item(a.in[17], 1024, 1536, WKVQ, a.in[16], BIG, 0, 0, scr, r, lane); continue; } r -= I_KV;
                if (r < I_SQ) { tr_item(a.in[3] + 1024 * 1024, 1024, 1024, WKVQ, a.in[2] + 1024, 0, 0, 1536, scr, r, lane); continue; } r -= I_SQ;
                if (r < I_SQ) { tr_item(a.in[4] + 1024 * 1024, 1024, 1024, (bf16_t*)(ws + WS_WOUT1), nullptr, BIG, 0, 0, scr, r, lane); continue; } r -= I_SQ;
                if (r < I_UP) { tr_item(a.in[21] + (size_t)1024 * 2 * DFF, 1024, 2 * DFF, (bf16_t*)(ws + WS_WUP1), a.in[20] + 1024, BIG, 1, 0, scr, r, lane); continue; } r -= I_UP;
                tr_item(a.in[24] + (size_t)DFF * 1024, DFF, 1024, (bf16_t*)(ws + WS_WDN1), nullptr, BIG, 0, 0, scr, r, lane);
            }
        }
        }
        asm volatile("s_waitcnt vmcnt(0)" ::: "memory"); __syncthreads(); __builtin_amdgcn_fence(__ATOMIC_ACQUIRE, "agent");
        { pg8::Gemm g{A3, BT3, NGRP * 2048, NGRP * 256, 384, 384, 384}; EpiS3 E{gb}; GEMM_CALL(EpiS3, GroupOrder, g, S, E); }
        { const int n2 = (NGRP * NB > G && NGRP * NB - G < G) ? NGRP * NB - G : 0;
          pg8::Gemm g2{memn, (const bf16_t*)(ws + WS_WMKV0), NB * MEMT, 1024, 1024, 1024, 1024}; pg8::StaticOrder S2;
          if (G - n2 >= 32) S2.init(NB * MEMT, 1024, 1 << 20, bx >= n2 ? bx - n2 : 1 << 20); else S2.init(NB * MEMT, 1024, G, bx);
          EpiStore E2{nullptr, (bf16_t*)(ws + WS_MEMKV0), 512, 512, (bf16_t*)(ws + WS_MEMKV1), 512}; GEMM_CALL(EpiStore, pg8::StaticOrder, g2, S2, E2); }
    }
    SEAM();
    { pg8::Gemm g{gb, WGLU, NTOK, DTOK, DTOK, DTOK, DTOK}; pg8::StaticOrder S; S.init(NTOK, DTOK, G, bx); EpiGlu E{gb, tokmix}; GEMM_CALL(EpiGlu, pg8::StaticOrder, g, S, E); }
    { const int nglu = (NTOK / 256) * 3; mem_attn_phase(proj0, (const bf16_t*)(ws + WS_MEMKV0), tokmix, (char*)lds, (nglu > G && nglu - G < G) ? nglu - G : 0, 0); }
    SEAM();
    {   constexpr int l = 0;
        { pg8::Gemm g{tokmix, (const bf16_t*)(ws + (l ? WS_WOUT1 : WS_WOUT0)), NTOK, 1024, 1024, 1024, 1024}; pg8::StaticOrder S; S.init(NTOK, 1024, G, bx);
          EpiResMix E{(const void*)hb, out, hb, ss + (l ? 3 : 1) * NTOK}; GEMM_CALL(EpiResMix, pg8::StaticOrder, g, S, E); }
        SEAM();
        { pg8::Gemm g{hb, (const bf16_t*)(ws + (l ? WS_WUP1 : WS_WUP0)), NTOK, 2 * DFF, 1024, 1024, 1024}; pg8::StaticOrder S; S.init(NTOK, 2 * DFF, G, bx);
          EpiUpConv E{ss + (l ? 3 : 1) * NTOK, abuf, a.in[22] + l * 3 * DFF, a.in[23] + l * DFF, ghead, gtail};
          pg8::gemm_phase<EpiUpConv, pg8::StaticOrder, true, true, 1>(ldsl, g, S, E); }
        SEAM();
        { pg8::Gemm g{abuf, (const bf16_t*)(ws + (l ? WS_WDN1 : WS_WDN0)), NTOK, 1024, DFF, DFF, DFF}; pg8::StaticOrder S; S.init(NTOK, 1024, G, bx);
          { TIDS(); pg8::Unit uu; for (int i = 0; S.next(i, uu); ++i) convfix_panel(abuf, ghead, gtail, a.in[22] + l * 3 * DFF, uu.pm, tid); }
          asm volatile("s_waitcnt vmcnt(0)" ::: "memory"); __syncthreads();
          EpiResMix E{(const void*)hb, out, hb, ss + 2 * NTOK}; GEMM_CALL(EpiResMix, pg8::StaticOrder, g, S, E); }
        SEAM();
    }
    {
            { TIDS(); fgate_phase(hb, ss + 2 * NTOK, a.in[18], a.in[16], a.in[19], logf, (LAS float*)ldsl, tid, wid, lane); }
            { pg8::Gemm g{hb, WKVQ, NTOK, 2560, 1024, 1024, 1024}; pg8::StaticOrder S; S.init(NTOK, 2560, G, bx);
              EpiKVQ E{ss + 2 * NTOK, kvb, proj1, kmaxp}; GEMM_CALL(EpiKVQ, pg8::StaticOrder, g, S, E); }
            SEAM();
            { TIDS(); fox_attn_phase(proj1, kvb, tokmix, logf, kmaxp, kmaxp + 1024, (char*)lds, ldsl, tid, wid, lane); }
            mem_attn_phase(proj1, (const bf16_t*)(ws + WS_MEMKV1), tokmix, (char*)lds, 0, 1);
            SEAM();
    }
    {   constexpr int l = 1;
        { pg8::Gemm g{tokmix, (const bf16_t*)(ws + (l ? WS_WOUT1 : WS_WOUT0)), NTOK, 1024, 1024, 1024, 1024}; pg8::StaticOrder S; S.init(NTOK, 1024, G, bx);
          EpiResMix E{(const void*)hb, out, hb, ss + (l ? 3 : 1) * NTOK}; GEMM_CALL(EpiResMix, pg8::StaticOrder, g, S, E); }
        SEAM();
        { pg8::Gemm g{hb, (const bf16_t*)(ws + (l ? WS_WUP1 : WS_WUP0)), NTOK, 2 * DFF, 1024, 1024, 1024}; pg8::StaticOrder S; S.init(NTOK, 2 * DFF, G, bx);
          EpiUpConv E{ss + (l ? 3 : 1) * NTOK, abuf, a.in[22] + l * 3 * DFF, a.in[23] + l * DFF, ghead, gtail};
          pg8::gemm_phase<EpiUpConv, pg8::StaticOrder, true, true, 1>(ldsl, g, S, E); }
        SEAM();
        { pg8::Gemm g{abuf, (const bf16_t*)(ws + (l ? WS_WDN1 : WS_WDN0)), NTOK, 1024, DFF, DFF, DFF}; pg8::StaticOrder S; S.init(NTOK, 1024, G, bx);
          { TIDS(); pg8::Unit uu; for (int i = 0; S.next(i, uu); ++i) convfix_panel(abuf, ghead, gtail, a.in[22] + l * 3 * DFF, uu.pm, tid); }
          asm volatile("s_waitcnt vmcnt(0)" ::: "memory"); __syncthreads();
          EpiResFfn E{(const void*)hb, out, (bf16_t*)nullptr, ss + 4 * NTOK}; GEMM_CALL(EpiResFfn, pg8::StaticOrder, g, S, E); }
        SEAM();
    }
    {
        TIDS();
        const float* ss4 = ss + 4 * NTOK; f32x4 gg[4];
#pragma unroll
        for (int j = 0; j < 4; ++j) gg[j] = ((const f32x4*)a.in[25])[64 * j + lane];
#pragma unroll 1
        for (int m0 = (bx * NWAVES + wid) * 4; m0 < NTOK; m0 += G * NWAVES * 4) {
            f32x4 v[4][4]; float rs[4];
#pragma unroll
            for (int r = 0; r < 4; ++r) { rs[r] = ss4[m0 + r];
#pragma unroll
                for (int j = 0; j < 4; ++j) v[r][j] = ((const f32x4*)(out + (size_t)(m0 + r) * 1024))[64 * j + lane]; }
#pragma unroll
            for (int r = 0; r < 4; ++r) { const float s = rstd_of(rs[r]);
#pragma unroll
                for (int j = 0; j < 4; ++j) ((f32x4*)(out + (size_t)(m0 + r) * 1024))[64 * j + lane] = v[r][j] * s * gg[j]; }
        }
    }
}

extern "C" void kernel_launch(void* const* d_in, const int* in_sizes, int n_in, void* d_out, int out_size, void* d_ws, size_t ws_size, hipStream_t stream) {
    static int grid = 0;
    if (grid == 0) {
        if (n_in != 26 || out_size != NTOK * DM || ws_size < WS_END) { fprintf(stderr, "kernel_launch: unexpected shapes (n_in %d out %d ws %zu)\n", n_in, out_size, ws_size); grid = -1; return; }
        int dev = 0, cus = 0, per_cu = 0;
        hipGetDevice(&dev); hipDeviceGetAttribute(&cus, hipDeviceAttributeMultiprocessorCount, dev);
        hipFuncSetAttribute((const void*)fwd_megakernel, hipFuncAttributeMaxDynamicSharedMemorySize, LDS_BYTES);
        hipOccupancyMaxActiveBlocksPerMultiprocessor(&per_cu, (const void*)fwd_megakernel, NTHREADS, LDS_BYTES);
        if (per_cu < 1) { fprintf(stderr, "kernel_launch: occupancy query reports %d blocks/CU\n", per_cu); per_cu = 1; }
        (void)hipGetLastError();
        grid = cus * per_cu;
        if (grid < 192) { fprintf(stderr, "kernel_launch: the S5 phase deals at most two units per workgroup: needs >= 192 resident workgroups, got %d\n", grid); grid = -1; return; }
    }
    if (grid < 0) return;
    Args a{};
    for (int i = 0; i < 26; ++i) a.in[i] = (const float*)d_in[i];
    a.out = (float*)d_out; a.ws = (unsigned char*)d_ws;
    void* args[] = {&a};
    hipError_t e = hipLaunchCooperativeKernel((const void*)fwd_megakernel, dim3(grid), dim3(NTHREADS), args, LDS_BYTES, stream);
    if (e != hipSuccess) fprintf(stderr, "cooperative launch failed: %s (grid %d)\n", hipGetErrorString(e), grid);
}
```

```cpp
#include <hip/hip_runtime.h>
#include <hip/hip_cooperative_groups.h>
#include <hip/hip_bf16.h>
#include <cstdio>
#include <cstdint>
#include <cmath>
namespace cg = cooperative_groups;
namespace pg8 {
#define PG8_LAS __attribute__((address_space(3)))
typedef unsigned short bf16_t;
typedef short bf16x8 __attribute__((ext_vector_type(8)));
typedef float f32x4 __attribute__((ext_vector_type(4)));
typedef unsigned u32x4 __attribute__((ext_vector_type(4)));
constexpr int BM = 256, BK = 64, HALF = 128, HTB = HALF * BK * 2  , STAGE_BYTES = 8 * HTB, NXCD = 8, WGM = 4;

__host__ __device__ __forceinline__ int lds_byte(int r, int c) { const int st = (r >> 4) * 2 + (c >> 5), rr = r & 15, cc = c & 31, ob = rr * 64 + cc * 2; return st * 1024 + (ob ^ (((ob >> 9) & 1) << 5)); }
__host__ __device__ __forceinline__ void stage_rc(int b, int& R, int& C) { const int st = b / 1024, sb = b % 1024, swz = sb ^ (((sb >> 9) & 1) << 5); R = (st >> 1) * 16 + swz / 64; C = (st & 1) * 32 + (swz % 64) / 2; }
__host__ __device__ __forceinline__ int perm32(int rho) { const int n = rho >> 4, i = rho & 15; return 8 * (i >> 2) + 4 * n + (i & 3); }

struct Unit { int pm, pn; };
struct Gemm { const bf16_t* A; const bf16_t* Bt; int M, N, K, lda, ldb; };

struct StaticOrder {
    int nM, nN, nwg, G, c;
    __host__ __device__ __forceinline__ void init(int M, int N, int G_, int c_) { nM = M / BM; nN = N / BM; nwg = nM * nN; G = G_; c = c_; }
    __host__ __device__ __forceinline__ bool next(int i, Unit& u) const {
        const long L = (long)i * G + c; if (L >= nwg) return false;
        int wgid = (int)L; { const int q = nwg / NXCD, r = nwg % NXCD, xcd = wgid % NXCD, off = wgid / NXCD; wgid = (xcd < r ? xcd * (q + 1) : r * (q + 1) + (xcd - r) * q) + off; }
        const int nig = WGM * nN, gid = wgid / nig, fm = gid * WGM, gsz = (nM - fm) < WGM ? (nM - fm) : WGM;
        u.pm = fm + ((wgid % nig) % gsz); u.pn = (wgid % nig) / gsz; return true;
    }
    __device__ __forceinline__ void a_ready(const Unit&) const {}
    __device__ __forceinline__ void done(const Unit&) const {}
};

__device__ __forceinline__ unsigned cvt_pk_bf16(float lo, float hi) { unsigned r; asm volatile("v_cvt_pk_bf16_f32 %0, %1, %2" : "=v"(r) : "v"(lo), "v"(hi)); return r; }
template <class Epi, class Sched, bool ALIGN_EPI = false, bool SP2 = false, int AMODE = 0>
__device__ __forceinline__ void gemm_phase(PG8_LAS unsigned char* lds, const Gemm g, const Sched& S, const Epi& E) {
    int tid_o = threadIdx.x; asm volatile("" : "+v"(tid_o)); const int tid = tid_o, wid = __builtin_amdgcn_readfirstlane(tid >> 6), lane = tid & 63, wr = wid >> 2, wc = wid & 3, fr = lane & 15, fq = lane >> 4;
    const int K = g.K, nt = K / BK;
    unsigned voffA[2], voffB[2];
#pragma unroll
    for (int i = 0; i < 2; ++i) { int R, C; stage_rc(tid * 16 + i * 8192, R, C); const int Rb = Epi::PERM ? ((R & ~31) + perm32(R & 31)) : R;
        const int Ra = (AMODE == 1) ? ((R >> 6) * 128 + (R & 15) * 8 + ((R >> 4) & 3)) : R;
        voffA[i] = (unsigned)(Ra * g.lda + C) * 2u; voffB[i] = (unsigned)(Rb * g.ldb + C) * 2u; }
    const size_t kstep = (size_t)(BK * 2);
    const size_t hstepA = (AMODE == 1) ? (size_t)4 * g.lda * 2 : (size_t)HALF * g.lda * 2, hstepB = (size_t)HALF * g.ldb * 2;
    const size_t tstepA = (size_t)BM * g.lda * 2, tstepB = (size_t)BM * g.ldb * 2;
    const unsigned ldsw = (unsigned)wid * 1024u;
    const int aoff = lds_byte(wr * 64 + fr, fq * 8), boff = lds_byte(wc * 32 + fr, fq * 8);
#define PG8_SA(b, h) (((b) * 2 + (h)) * HTB)
#define PG8_SB(b, h) ((4 + (b) * 2 + (h)) * HTB)
#define PG8_STAGE(bufoff, gbase, voff) do { _Pragma("unroll") for (int _i = 0; _i < 2; ++_i) \
        __builtin_amdgcn_global_load_lds((const unsigned*)((const char*)(gbase) + (voff)[_i]), (PG8_LAS unsigned*)(lds + (bufoff) + ldsw + _i * 8192), 16, 0, 0); } while (0)
#define PG8_LDA(dst, b, h) do { _Pragma("unroll") for (int m = 0; m < 4; ++m) _Pragma("unroll") for (int k = 0; k < 2; ++k) dst[m][k] = *(const PG8_LAS bf16x8*)(lds + PG8_SA(b, h) + aoff + m * 2048 + k * 1024); } while (0)
#define PG8_LDB(dst, b, h) do { _Pragma("unroll") for (int n = 0; n < 2; ++n) _Pragma("unroll") for (int k = 0; k < 2; ++k) dst[n][k] = *(const PG8_LAS bf16x8*)(lds + PG8_SB(b, h) + boff + n * 2048 + k * 1024); } while (0)
#define PG8_MMA(ai, bj, At, Bt) do { __builtin_amdgcn_s_setprio(1); _Pragma("unroll") for (int m = 0; m < 4; ++m) _Pragma("unroll") for (int n = 0; n < 2; ++n) _Pragma("unroll") for (int k = 0; k < 2; ++k) \
        acc[ai][bj][m][n] = __builtin_amdgcn_mfma_f32_16x16x32_bf16(Bt[n][k], At[m][k], acc[ai][bj][m][n], 0, 0, 0); __builtin_amdgcn_s_setprio(0); } while (0)
#define PG8_WAIT_V(n) asm volatile("s_waitcnt vmcnt(" #n ")" ::: "memory")
#define PG8_WAIT_L(n) asm volatile("s_waitcnt lgkmcnt(" #n ")" ::: "memory")
#define PG8_BAR __builtin_amdgcn_s_barrier()
#define PG8_SCHED __builtin_amdgcn_sched_barrier(0)
    Unit cur, nxt; int ui = 0;
    if (!S.next(0, cur)) return;
    f32x4 acc[2][2][4][2];
#pragma unroll
    for (int a = 0; a < 2; ++a)
#pragma unroll
        for (int b = 0; b < 2; ++b)
#pragma unroll
            for (int m = 0; m < 4; ++m)
#pragma unroll
                for (int n = 0; n < 2; ++n) acc[a][b][m][n] = (f32x4){0.f, 0.f, 0.f, 0.f};
    bf16x8 At[4][2], B0[2][2], B1[2][2];
    const char* cA = (const char*)g.A + (size_t)cur.pm * tstepA; const char* cB = (const char*)g.Bt + (size_t)cur.pn * tstepB;
    S.a_ready(cur);
    if constexpr (SP2) {
        PG8_STAGE(PG8_SB(0, 0), cB, voffB); PG8_STAGE(PG8_SB(0, 1), cB + hstepB, voffB); PG8_STAGE(PG8_SA(0, 0), cA, voffA); PG8_STAGE(PG8_SA(0, 1), cA + hstepA, voffA);
        if (wr == 1) PG8_BAR;
        PG8_WAIT_V(2); PG8_BAR;
        PG8_STAGE(PG8_SB(1, 0), cB + kstep, voffB); PG8_STAGE(PG8_SA(1, 0), cA + kstep, voffA); PG8_STAGE(PG8_SB(1, 1), cB + hstepB + kstep, voffB);
        PG8_WAIT_V(6); PG8_BAR;
    } else {
        PG8_STAGE(PG8_SB(0, 0), cB, voffB); PG8_STAGE(PG8_SA(0, 0), cA, voffA); PG8_STAGE(PG8_SB(0, 1), cB + hstepB, voffB); PG8_STAGE(PG8_SA(0, 1), cA + hstepA, voffA);
        if (wr == 1) PG8_BAR;
        PG8_WAIT_V(4); PG8_BAR;
        PG8_STAGE(PG8_SB(1, 0), cB + kstep, voffB); PG8_STAGE(PG8_SA(1, 0), cA + kstep, voffA); PG8_STAGE(PG8_SB(1, 1), cB + hstepB + kstep, voffB);
        PG8_WAIT_V(6); PG8_BAR;
    }
    for (;;) {
        const bool has_next = S.next(ui + 1, nxt);
        const char* nA = has_next ? (const char*)g.A + (size_t)nxt.pm * tstepA : cA; const char* nB = has_next ? (const char*)g.Bt + (size_t)nxt.pn * tstepB : cB;
        for (int t = 0; t < nt; t += 2) {
            const bool last = (t == nt - 2);
            const char* a1 = cA + (size_t)(t + 1) * kstep;
            const char* a2 = last ? nA : cA + (size_t)(t + 2) * kstep; const char* b2 = last ? nB : cB + (size_t)(t + 2) * kstep;
            const char* a3 = a2 + kstep; const char* b3 = b2 + kstep;
            if (last && has_next) S.a_ready(nxt);
            if constexpr (SP2) {
            PG8_LDB(B0, 0, 0); PG8_LDB(B1, 0, 1); PG8_SCHED; PG8_LDA(At, 0, 0); PG8_STAGE(PG8_SA(1, 1), a1 + hstepA, voffA);
            PG8_WAIT_V(8); PG8_WAIT_L(0); PG8_BAR; PG8_MMA(0, 0, At, B0); PG8_MMA(0, 1, At, B1); PG8_BAR; PG8_SCHED;
            PG8_LDA(At, 0, 1); PG8_STAGE(PG8_SB(0, 0), b2, voffB); PG8_STAGE(PG8_SB(0, 1), b2 + hstepB, voffB); PG8_STAGE(PG8_SA(0, 0), a2, voffA);
            PG8_WAIT_V(8); PG8_WAIT_L(0); PG8_BAR; PG8_MMA(1, 0, At, B0); PG8_MMA(1, 1, At, B1); PG8_BAR; PG8_SCHED;
            PG8_LDB(B0, 1, 0); PG8_LDB(B1, 1, 1); PG8_SCHED; PG8_LDA(At, 1, 0); PG8_STAGE(PG8_SA(0, 1), a2 + hstepA, voffA);
            PG8_WAIT_V(8); PG8_WAIT_L(0); PG8_BAR; PG8_MMA(0, 0, At, B0); PG8_MMA(0, 1, At, B1); PG8_BAR; PG8_SCHED;
            PG8_LDA(At, 1, 1); PG8_STAGE(PG8_SB(1, 0), b3, voffB); PG8_STAGE(PG8_SB(1, 1), b3 + hstepB, voffB); PG8_STAGE(PG8_SA(1, 0), a3, voffA);
            PG8_WAIT_V(8); PG8_WAIT_L(0); PG8_BAR; PG8_MMA(1, 0, At, B0); PG8_MMA(1, 1, At, B1); PG8_BAR; PG8_SCHED;
            } else {
            PG8_LDB(B0, 0, 0); PG8_SCHED; PG8_LDA(At, 0, 0); PG8_STAGE(PG8_SA(1, 1), a1 + hstepA, voffA);
            PG8_WAIT_L(8); PG8_BAR; PG8_WAIT_L(0); PG8_MMA(0, 0, At, B0); PG8_BAR; PG8_SCHED;
            PG8_LDB(B1, 0, 1); PG8_STAGE(PG8_SB(0, 0), b2, voffB);
            PG8_BAR; PG8_WAIT_L(0); PG8_MMA(0, 1, At, B1); PG8_BAR;
            PG8_LDA(At, 0, 1); PG8_STAGE(PG8_SA(0, 0), a2, voffA);
            PG8_BAR; PG8_WAIT_L(0); PG8_MMA(1, 0, At, B0); PG8_BAR; PG8_SCHED;
            PG8_STAGE(PG8_SB(0, 1), b2 + hstepB, voffB);
            PG8_WAIT_V(6); PG8_BAR; PG8_MMA(1, 1, At, B1); PG8_BAR;
            PG8_LDB(B0, 1, 0); PG8_SCHED; PG8_LDA(At, 1, 0); PG8_STAGE(PG8_SA(0, 1), a2 + hstepA, voffA);
            PG8_WAIT_L(8); PG8_BAR; PG8_WAIT_L(0); PG8_MMA(0, 0, At, B0); PG8_BAR; PG8_SCHED;
            PG8_LDB(B1, 1, 1); PG8_STAGE(PG8_SB(1, 0), b3, voffB);
            PG8_BAR; PG8_WAIT_L(0); PG8_MMA(0, 1, At, B1); PG8_BAR;
            PG8_LDA(At, 1, 1); PG8_STAGE(PG8_SA(1, 0), a3, voffA);
            PG8_BAR; PG8_WAIT_L(0); PG8_MMA(1, 0, At, B0); PG8_BAR; PG8_SCHED;
            PG8_STAGE(PG8_SB(1, 1), b3 + hstepB, voffB);
            PG8_WAIT_V(6); PG8_BAR; PG8_MMA(1, 1, At, B1); PG8_BAR;
            }
        }
        if constexpr (ALIGN_EPI) { if (wr == 0) PG8_BAR; }
        if constexpr (!Epi::AFTER_DRAIN) { E(acc, cur, wr, wc, fr, fq); S.done(cur); }
        if (!has_next) break;
#pragma unroll
        for (int a = 0; a < 2; ++a)
#pragma unroll
            for (int b = 0; b < 2; ++b)
#pragma unroll
                for (int m = 0; m < 4; ++m)
#pragma unroll
                    for (int n = 0; n < 2; ++n) acc[a][b][m][n] = (f32x4){0.f, 0.f, 0.f, 0.f};
        cur = nxt; cA = nA; cB = nB; ++ui;
        if constexpr (ALIGN_EPI) { if (wr == 1) PG8_BAR; }
    }
    PG8_WAIT_V(0);
    if constexpr (!ALIGN_EPI) { if (wr == 0) PG8_BAR; }
    PG8_BAR;
    if constexpr (Epi::AFTER_DRAIN) { E.fused(acc, cur, wr, wc, fr, fq, lds, wid, lane); S.done(cur); }
#undef PG8_SA
#undef PG8_SB
#undef PG8_STAGE
#undef PG8_LDA
#undef PG8_LDB
#undef PG8_MMA
#undef PG8_WAIT_V
#undef PG8_WAIT_L
#undef PG8_BAR
#undef PG8_SCHED
}
}
#include <hip/hip_bf16.h>
namespace attn_body {
using bf16=__hip_bfloat16;
using bf16x8=__attribute__((ext_vector_type(8)))short;
using s16x4=__attribute__((ext_vector_type(4)))short;
using f32x16=__attribute__((ext_vector_type(16)))float;
using u32x4=__attribute__((ext_vector_type(4)))unsigned;
constexpr int D=64;
constexpr int NW=8,QBLK=32,QB=QBLK*NW,KVBLK=64;
constexpr int ATTN_UNIT_ROWS=QB; typedef float f32x4_t __attribute__((ext_vector_type(4))); typedef const __attribute__((address_space(3))) f32x4_t* lds_f4p;
__device__ __forceinline__ int crow(int r,int hi){return (r&3)+8*(r>>2)+4*hi;}
#define SBAR() __builtin_amdgcn_sched_barrier(0)
__device__ __forceinline__ void cmask(f32x16&p0,f32x16&p1,int jb,int qrel,int hi){
  const float NEG=-INFINITY; int kb=64*jb+4*hi;
  #pragma unroll
  for(int r=0;r<16;++r){int kv=kb+(r&3)+8*(r>>2); if(kv>qrel)p0[r]=NEG; if(kv+32>qrel)p1[r]=NEG;}
}

constexpr int NSLOT=3, SLOTB=8192;
constexpr int LDS_K=0, LDS_V=NSLOT*SLOTB, LDS_WS=2*NSLOT*SLOTB, LDS_OST=LDS_WS+NW*64*4, LDS_BYTES=LDS_OST+NW*4096;
constexpr float C2=0.125f*1.4426950408889634f;
__device__ __forceinline__ void glds16(const void*gsrc,unsigned lds_dst){unsigned keep;
  asm volatile("s_mov_b32 %0, m0\n\ts_mov_b32 m0, %2\n\ts_nop 0\n\tglobal_load_lds_dwordx4 %1, off\n\ts_mov_b32 m0, %0":"=&s"(keep):"v"(gsrc),"s"(lds_dst):"memory");}
__device__ __forceinline__ float max3f(float a,float b,float c){float r;asm("v_max3_f32 %0, %1, %2, %3":"=v"(r):"v"(a),"v"(b),"v"(c));return r;}
__device__ __forceinline__ float max2f(float a,float b){float r;asm("v_max_f32_e32 %0, %1, %2":"=v"(r):"v"(a),"v"(b));return r;}
__device__ __forceinline__ float fadd_s(float a,float b){float r;asm("v_add_f32_e32 %0, %1, %2":"=v"(r):"v"(a),"v"(b));return r;}
__device__ __forceinline__ float fsub_s(float a,float b){float r;asm("v_sub_f32_e32 %0, %1, %2":"=v"(r):"v"(a),"v"(b));return r;}
typedef float f32x2_t __attribute__((ext_vector_type(2))); typedef __bf16 bf16x2_t __attribute__((ext_vector_type(2)));
__device__ __forceinline__ unsigned cvtpk_s(float lo,float hi){f32x2_t v={lo,hi};bf16x2_t b=__builtin_convertvector(v,bf16x2_t);return __builtin_bit_cast(unsigned,b);}
#define WAIT_BAR(N) asm volatile("s_waitcnt vmcnt(" #N ") lgkmcnt(0)\n\ts_barrier":::"memory")

__device__ __forceinline__ void qkt(f32x16&p0,f32x16&p1,const char*Kslot,const bf16x8*qr,const f32x16&c0,const f32x16&c1,int r32,int hi){
  const char*kb=Kslot+hi*1024+r32*16;
  #pragma unroll
  for(int d0=0;d0<4;++d0){
    const bf16x8 b0=*reinterpret_cast<const bf16x8*>(kb+d0*2048);
    const bf16x8 b1=*reinterpret_cast<const bf16x8*>(kb+d0*2048+512);
    if(d0==0){p0=__builtin_amdgcn_mfma_f32_32x32x16_bf16(b0,qr[0],c0,0,0,0);p1=__builtin_amdgcn_mfma_f32_32x32x16_bf16(b1,qr[0],c1,0,0,0);}
    else{p0=__builtin_amdgcn_mfma_f32_32x32x16_bf16(b0,qr[d0],p0,0,0,0);p1=__builtin_amdgcn_mfma_f32_32x32x16_bf16(b1,qr[d0],p1,0,0,0);}}
}
typedef __attribute__((address_space(3))) const char* lds_cptr;
typedef short v4i16_t __attribute__((ext_vector_type(4)));
__device__ __forceinline__ void kload8(bf16x8*kf,lds_cptr kp){
  kf[0]=*(const __attribute__((address_space(3))) bf16x8*)(kp);      kf[1]=*(const __attribute__((address_space(3))) bf16x8*)(kp+512);
  kf[2]=*(const __attribute__((address_space(3))) bf16x8*)(kp+2048); kf[3]=*(const __attribute__((address_space(3))) bf16x8*)(kp+2560);
  kf[4]=*(const __attribute__((address_space(3))) bf16x8*)(kp+4096); kf[5]=*(const __attribute__((address_space(3))) bf16x8*)(kp+4608);
  kf[6]=*(const __attribute__((address_space(3))) bf16x8*)(kp+6144); kf[7]=*(const __attribute__((address_space(3))) bf16x8*)(kp+6656);
}
__device__ __forceinline__ void kload2(bf16x8*kf,lds_cptr kp,int j){ kf[2*j]=*(const __attribute__((address_space(3))) bf16x8*)(kp+j*2048); kf[2*j+1]=*(const __attribute__((address_space(3))) bf16x8*)(kp+j*2048+512); }
__device__ __forceinline__ s16x4 vtr(lds_cptr p){ return __builtin_bit_cast(s16x4,__builtin_amdgcn_ds_read_tr16_b64_v4i16((__attribute__((address_space(3))) v4i16_t*)p)); }
__device__ __forceinline__ float rowmax(const f32x16&p0,const f32x16&p1){
  float a=max3f(p0[0],p0[1],p1[0]),b=max3f(p0[2],p0[3],p1[1]);a=max3f(a,p1[2],p1[3]);
  #pragma unroll
  for(int r=4;r<16;r+=4){a=max3f(a,p0[r],p0[r+1]);b=max3f(b,p0[r+2],p0[r+3]);a=max3f(a,p1[r],p1[r+1]);b=max3f(b,p1[r+2],p1[r+3]);}
  const float m=max2f(a,b);
  auto rr=__builtin_amdgcn_permlane32_swap(__float_as_uint(m),__float_as_uint(m),false,false);
  return max2f(__uint_as_float(rr[0]),__uint_as_float(rr[1]));
}
__device__ __forceinline__ void pv(f32x16*o,int vb,bf16x8 pa0,bf16x8 pa1,bf16x8 pa2,bf16x8 pa3){
  #pragma unroll
  for(int d0=0;d0<2;++d0){s16x4 lo[4],hi[4];
    #pragma unroll
    for(int ks=0;ks<4;++ks){
      asm volatile("ds_read_b64_tr_b16 %0,%1 offset:%c2":"=&v"(lo[ks]):"v"(vb),"i"(d0*4096+ks*1024):"memory");
      asm volatile("ds_read_b64_tr_b16 %0,%1 offset:%c2":"=&v"(hi[ks]):"v"(vb),"i"(d0*4096+ks*1024+512):"memory");}
    asm volatile("s_waitcnt lgkmcnt(0)":::"memory");SBAR();
    #define PK(k) (bf16x8){lo[k][0],lo[k][1],lo[k][2],lo[k][3],hi[k][0],hi[k][1],hi[k][2],hi[k][3]}
    o[d0]=__builtin_amdgcn_mfma_f32_32x32x16_bf16(pa0,PK(0),o[d0],0,0,0);
    o[d0]=__builtin_amdgcn_mfma_f32_32x32x16_bf16(pa1,PK(1),o[d0],0,0,0);
    o[d0]=__builtin_amdgcn_mfma_f32_32x32x16_bf16(pa2,PK(2),o[d0],0,0,0);
    o[d0]=__builtin_amdgcn_mfma_f32_32x32x16_bf16(pa3,PK(3),o[d0],0,0,0);
    #undef PK
  }
}

#ifndef ATTN_STORE16
#define ATTN_STORE16(p,v) (*(u32x4*)(p)=(v))
#endif
template<int THRL,bool CAUSAL,bool BIAS,int PQ,int PKV,bool REV=false,bool SKIP=false> __device__ __forceinline__ void attn_unit(const bf16*Q0,const bf16*__restrict__ Kh,const bf16*__restrict__ Vh,bf16*O0,const int NTI,lds_f4p btab,char*shm,float kmaxv=0.f,__attribute__((address_space(3))) float*xq=nullptr){
  int NT=NTI;
  int tid_o=threadIdx.x; asm volatile("":"+v"(tid_o)); const int tid=tid_o,lane=tid&63,r32=lane&31,hi=lane>>5; const int wid=__builtin_amdgcn_readfirstlane(tid>>6);
  const bf16*Qw=Q0+(long)(wid*QBLK)*PQ;
  const unsigned lds0=(unsigned)(uintptr_t)shm;
  float*wsf=(float*)(shm+LDS_WS)+wid*64;
  const bf16*ksrc=Kh+(long)lane*PKV+wid*8;
  const bf16*vsrc=Vh+(long)(16*(wid&3)+(lane>>2))*PKV+(wid>>2)*32+(lane&3)*8;
  const unsigned kdst=lds0+LDS_K+wid*1024, vdst=lds0+LDS_V+wid*1024;
  #define TIX(t) (REV?(NTI-1-(t)):(t))
  #define DMA_K(t,slot) glds16(ksrc+(long)TIX(t)*KVBLK*PKV,(unsigned)__builtin_amdgcn_readfirstlane(kdst+(slot)))
  #define DMA_V(t,slot) glds16(vsrc+(long)TIX(t)*KVBLK*PKV,(unsigned)__builtin_amdgcn_readfirstlane(vdst+(slot)))
  const int vb0=(int)(lds0+LDS_V)+((lane>>4)&1)*32+(lane&3)*8+(4*hi+((lane&15)>>2))*64;
  const char*Kbase=shm+LDS_K; bf16x8 kf[8];
  const lds_cptr shm3=(lds_cptr)shm; const lds_cptr kp0=shm3+LDS_K+hi*1024+r32*16; const lds_cptr vp0=shm3+LDS_V+((lane>>4)&1)*32+(lane&3)*8+(4*hi+((lane&15)>>2))*64;
  DMA_K(0,0);DMA_V(0,0);DMA_K(1,SLOTB);
  bf16x8 qr[4];
  #pragma unroll
  for(int d0=0;d0<4;++d0)qr[d0]=*reinterpret_cast<const bf16x8*>(&Qw[(long)r32*PQ+d0*16+hi*8]);
  if(SKIP){ float qsq=0.f;
    _Pragma("unroll") for(int d0=0;d0<4;++d0) _Pragma("unroll") for(int e=0;e<8;++e){ const float f=__uint_as_float(((unsigned)(unsigned short)qr[d0][e])<<16); qsq+=f*f; }
    { auto rr=__builtin_amdgcn_permlane32_swap(__float_as_uint(qsq),__float_as_uint(qsq),false,false); qsq=__uint_as_float(rr[0])+__uint_as_float(rr[1]); }
    _Pragma("unroll") for(int o_=1;o_<32;o_<<=1) qsq=__builtin_fmaxf(qsq,__shfl_xor(qsq,o_));
    if(lane==0) xq[wid]=qsq; }
  float mhat=0.f,l_reg=0.f;f32x16 o[2];o[0]=f32x16{};o[1]=f32x16{};f32x16 negm=f32x16{}; if(!BIAS){asm volatile("":"+v"(negm));}
  const int qrel=wid*QBLK+r32;
  #define CMASK(P0,P1,t) do{ if(CAUSAL){int jb_=REV?3-(t):(t)-(NT-4); if(jb_>=0)cmask(P0,P1,jb_,qrel,hi);} }while(0)
  bool resc=false;
  #define START(P0,P1) do{ const float rm=rowmax(P0,P1); resc=false; \
    { const float dl=(rm==-INFINITY)?0.f:rm; mhat=fadd_s(mhat,dl); \
      _Pragma("unroll") for(int r=0;r<16;++r){P0[r]=fsub_s(P0[r],dl);P1[r]=fsub_s(P1[r],dl);} \
      if(!BIAS){ _Pragma("unroll") for(int r=0;r<16;++r)negm[r]=-mhat; asm volatile("":"+v"(negm)); } } \
    _Pragma("unroll") for(int r=0;r<16;++r)P0[r]=__builtin_amdgcn_exp2f(P0[r]); }while(0)
  #define RESC() do{ if(resc){ asm volatile("s_waitcnt lgkmcnt(0)":::"memory"); \
      _Pragma("unroll") for(int d_=0;d_<2;++d_) _Pragma("unroll") for(int r=0;r<16;++r)o[d_][r]*=wsf[crow(r,hi)]; } }while(0)
  #define BFILL(C0,C1,t) do{ if(BIAS){ const lds_f4p bt_=btab+TIX(t)*16+hi; \
    _Pragma("unroll") for(int j_=0;j_<4;++j_){ const f32x4_t v0_=bt_[2*j_], v1_=bt_[2*j_+8]; \
      C0[4*j_]=v0_[0]-mhat; C0[4*j_+1]=v0_[1]-mhat; C0[4*j_+2]=v0_[2]-mhat; C0[4*j_+3]=v0_[3]-mhat; \
      C1[4*j_]=v1_[0]-mhat; C1[4*j_+1]=v1_[1]-mhat; C1[4*j_+2]=v1_[2]-mhat; C1[4*j_+3]=v1_[3]-mhat; } } }while(0)
  f32x16 pA0,pA1,pB0,pB1;
  int sl_prev=0,sl_cur=0,sl_next=SLOTB;
  #define ROT() do{sl_prev=sl_cur;sl_cur=sl_next;sl_next=(sl_next==(NSLOT-1)*SLOTB)?0:sl_next+SLOTB;}while(0)
  DMA_K(2,2*SLOTB);
  WAIT_BAR(3);
  if(SKIP){
    float q2=xq[0]; _Pragma("unroll") for(int w_=1;w_<8;++w_) q2=__builtin_fmaxf(q2,xq[w_]);
    const float qk2=2.f*__builtin_sqrtf(q2)*kmaxv; const __attribute__((address_space(3))) float*bf_=(const __attribute__((address_space(3))) float*)btab; const float bq0=bf_[64*(NTI-4)];
    for(int c_=4;c_<NTI;c_+=2){ if(bf_[64*(NTI-c_)-1]-bq0+qk2<-170.f){ NT=c_; break; } } }
  BFILL(pA0,pA1,0); qkt(pA0,pA1,Kbase,qr,BIAS?pA0:negm,BIAS?pA1:negm,r32,hi);asm volatile("s_nop 15\n\ts_nop 7":"+v"(pA0),"+v"(pA1));CMASK(pA0,pA1,0);
  START(pA0,pA1);
  BFILL(pB0,pB1,1);
  _Pragma("unroll") for(int r=0;r<16;++r)pA1[r]=__builtin_amdgcn_exp2f(pA1[r]);
  WAIT_BAR(0);
  DMA_K(3,0);DMA_V(1,SLOTB);
  ROT();
  kload8(kf,kp0+sl_cur);
  WAIT_BAR(2);
  s16x4 vlo[8],vhi[8]; u32x4 pw0,pw1,pw2,pw3;
  #define PKW(P,B) cvtpk_s(P[B],P[B+1])
  #define PAF(k) __builtin_bit_cast(bf16x8,pw##k)
  #define VFR(i) (bf16x8){vlo[i][0],vlo[i][1],vlo[i][2],vlo[i][3],vhi[i][0],vhi[i][1],vhi[i][2],vhi[i][3]}
  #define PIN(x) asm volatile("":"+v"(x))
  #define MX3(a,b,c) __builtin_fmaxf(__builtin_fmaxf((a),(b)),(c))
  #define GAPA(MF,A0,A1,A2,A3,W0,W1,PW) do{ MF; sacc+=A0; sacc+=A1; sacc+=A2; sacc+=A3; PIN(sacc); W0; W1; PIN(PW); SBAR(); }while(0)
  #define EX(v) __builtin_amdgcn_exp2f(v)
  #define GAPB(MF,X,B,FL,PN,JJ,OFFN) do{ MF; X[B]=EX(X[B]); X[B+1]=EX(X[B+1]); X[B+2]=EX(X[B+2]); X[B+3]=EX(X[B+3]); \
    if(BIAS&&(FL)){ { f32x2_t a_={bq_[0],bq_[1]}, b_={bq_[2],bq_[3]}; const f32x2_t m2_={mhat,mhat}; a_-=m2_; b_-=m2_; PN[4*(JJ)]=a_[0]; PN[4*(JJ)+1]=a_[1]; PN[4*(JJ)+2]=b_[0]; PN[4*(JJ)+3]=b_[1]; } if((OFFN)>=0) bq_=btn_[(OFFN)>=0?(OFFN):0]; PIN(PN); } PIN(X); SBAR(); }while(0)
  #define VRD(i) do{ vlo[i]=vtr(vp_+(((i)>>2)*4096+((i)&3)*1024)); vhi[i]=vtr(vp_+(((i)>>2)*4096+((i)&3)*1024+512)); }while(0)
  #define KRD(G,j) do{ if(G){ kload2(kf,kp0+sl_next,j); SBAR(); } }while(0)
  #define STEP(C0,C1,P0,P1,t,GK,GV,GL) do{ SBAR(); \
    const lds_cptr vp_=vp0+sl_prev; \
    VRD(0); SBAR(); float sacc=(P0[0]+P0[1]); \
    GAPA(C0=__builtin_amdgcn_mfma_f32_32x32x16_bf16(kf[0],qr[0],BIAS?C0:negm,0,0,0), P0[2],P0[3],P0[4],P0[5],     pw0[0]=PKW(P0,0), pw0[1]=PKW(P0,2), pw0); \
    VRD(4); SBAR(); GAPA(C1=__builtin_amdgcn_mfma_f32_32x32x16_bf16(kf[1],qr[0],BIAS?C1:negm,0,0,0), P0[6],P0[7],P0[8],P0[9],     pw0[2]=PKW(P0,4), pw0[3]=PKW(P0,6), pw0); \
    VRD(1); SBAR(); GAPA(C0=__builtin_amdgcn_mfma_f32_32x32x16_bf16(kf[2],qr[1],C0,0,0,0),   P0[10],P0[11],P0[12],P0[13], pw1[0]=PKW(P0,8), pw1[1]=PKW(P0,10), pw1); \
    VRD(5); SBAR(); GAPA(C1=__builtin_amdgcn_mfma_f32_32x32x16_bf16(kf[3],qr[1],C1,0,0,0),   P0[14],P0[15],P1[0],P1[1],   pw1[2]=PKW(P0,12),pw1[3]=PKW(P0,14), pw1); \
    VRD(2); SBAR(); GAPA(C0=__builtin_amdgcn_mfma_f32_32x32x16_bf16(kf[4],qr[2],C0,0,0,0),   P1[2],P1[3],P1[4],P1[5],     pw2[0]=PKW(P1,0), pw2[1]=PKW(P1,2), pw2); \
    VRD(6); SBAR(); GAPA(C1=__builtin_amdgcn_mfma_f32_32x32x16_bf16(kf[5],qr[2],C1,0,0,0),   P1[6],P1[7],P1[8],P1[9],     pw2[2]=PKW(P1,4), pw2[3]=PKW(P1,6), pw2); \
    VRD(3); SBAR(); GAPA(C0=__builtin_amdgcn_mfma_f32_32x32x16_bf16(kf[6],qr[3],C0,0,0,0),   P1[10],P1[11],P1[12],P1[13], pw3[0]=PKW(P1,8), pw3[1]=PKW(P1,10), pw3); \
    VRD(7); SBAR(); GAPA(C1=__builtin_amdgcn_mfma_f32_32x32x16_bf16(kf[7],qr[3],C1,0,0,0),   P1[14],P1[15],0.f,0.f,       pw3[2]=PKW(P1,12),pw3[3]=PKW(P1,14), pw3); \
    l_reg+=sacc; \
    if(GK){DMA_K((t)+3,sl_cur);} if(GV){DMA_V((t)+1,sl_next);} \
    CMASK(C0,C1,t); \
    { float a=MX3(C0[0],C0[1],C1[0]),b=MX3(C0[2],C0[3],C1[1]); a=MX3(a,C1[2],C1[3]); \
      _Pragma("unroll") for(int r=4;r<16;r+=4){a=MX3(a,C0[r],C0[r+1]);b=MX3(b,C0[r+2],C0[r+3]);a=MX3(a,C1[r],C1[r+1]);b=MX3(b,C1[r+2],C1[r+3]);} \
      float rm=__builtin_fmaxf(a,b); { auto rr=__builtin_amdgcn_permlane32_swap(__float_as_uint(rm),__float_as_uint(rm),false,false); rm=__builtin_fmaxf(__uint_as_float(rr[0]),__uint_as_float(rr[1])); } \
      resc=false; \
      if(__builtin_expect(__any(rm>(float)THRL),0)){ const float dl=__builtin_fmaxf(rm,0.f); mhat+=dl; \
        _Pragma("unroll") for(int r=0;r<16;++r){C0[r]-=dl;C1[r]-=dl;} \
        if(!BIAS){ _Pragma("unroll") for(int r=0;r<16;++r)negm[r]=-mhat; asm volatile("":"+v"(negm)); } \
        const float f=__builtin_amdgcn_exp2f(-dl); l_reg*=f; if(hi==0)wsf[r32]=f; resc=true; } } \
    const lds_f4p btn_=btab+TIX((t)+1)*16+hi; f32x4_t bq_; if(BIAS&&(GL)) bq_=btn_[0]; \
    SBAR(); \
    GAPB(o[0]=__builtin_amdgcn_mfma_f32_32x32x16_bf16(PAF(0),VFR(0),o[0],0,0,0), C0,0, GL,P0,0,2); \
    GAPB(o[1]=__builtin_amdgcn_mfma_f32_32x32x16_bf16(PAF(0),VFR(4),o[1],0,0,0), C0,4, GL,P0,1,4); \
    KRD(GL,0); GAPB(o[0]=__builtin_amdgcn_mfma_f32_32x32x16_bf16(PAF(1),VFR(1),o[0],0,0,0), C0,8, GL,P0,2,6); \
    KRD(GL,1); GAPB(o[1]=__builtin_amdgcn_mfma_f32_32x32x16_bf16(PAF(1),VFR(5),o[1],0,0,0), C0,12, GL,P0,3,8); \
    KRD(GL,2); GAPB(o[0]=__builtin_amdgcn_mfma_f32_32x32x16_bf16(PAF(2),VFR(2),o[0],0,0,0), C1,0, GL,P1,0,10); \
    KRD(GL,3); GAPB(o[1]=__builtin_amdgcn_mfma_f32_32x32x16_bf16(PAF(2),VFR(6),o[1],0,0,0), C1,4, GL,P1,1,12); \
    GAPB(o[0]=__builtin_amdgcn_mfma_f32_32x32x16_bf16(PAF(3),VFR(3),o[0],0,0,0), C1,8, GL,P1,2,14); \
    GAPB(o[1]=__builtin_amdgcn_mfma_f32_32x32x16_bf16(PAF(3),VFR(7),o[1],0,0,0), C1,12, GL,P1,3,-1); \
    }while(0)
  int t=1;
  #undef CMASK
  #define CMASK(P0,P1,t) do{ if(REV&&CAUSAL){int jb_=3-(t); if(jb_>=0)cmask(P0,P1,jb_,qrel,hi);} }while(0)
  for(;t+5<NT;t+=2){
    STEP(pB0,pB1,pA0,pA1,t,true,true,true);     WAIT_BAR(2); RESC(); ROT();
    STEP(pA0,pA1,pB0,pB1,t+1,true,true,true);   WAIT_BAR(2); RESC(); ROT();
  }
  #undef CMASK
  #define CMASK(P0,P1,t) do{ if(CAUSAL){int jb_=REV?3-(t):(t)-(NT-4); if(jb_>=0)cmask(P0,P1,jb_,qrel,hi);} }while(0)
  #define ENDW(tt) do{ if((tt)+3<NT){WAIT_BAR(2);} else if((tt)+2<NT){WAIT_BAR(1);} else {WAIT_BAR(0);} }while(0)
  for(;t+1<NT;t+=2){
    STEP(pB0,pB1,pA0,pA1,t,(t+3<NT),(t+1<NT),(t+1<NT));       ENDW(t);   RESC(); ROT();
    STEP(pA0,pA1,pB0,pB1,t+1,(t+4<NT),(t+2<NT),(t+2<NT));     ENDW(t+1); RESC(); ROT();
  }
  STEP(pB0,pB1,pA0,pA1,NT-1,false,false,false); RESC();
  { float sacc=pB0[0]+pB0[1]; _Pragma("unroll") for(int r=2;r<16;++r)sacc+=pB0[r]; _Pragma("unroll") for(int r=0;r<16;++r)sacc+=pB1[r]; l_reg+=sacc;
    pw0=(u32x4){PKW(pB0,0),PKW(pB0,2),PKW(pB0,4),PKW(pB0,6)};pw1=(u32x4){PKW(pB0,8),PKW(pB0,10),PKW(pB0,12),PKW(pB0,14)};pw2=(u32x4){PKW(pB1,0),PKW(pB1,2),PKW(pB1,4),PKW(pB1,6)};pw3=(u32x4){PKW(pB1,8),PKW(pB1,10),PKW(pB1,12),PKW(pB1,14)};
    SBAR(); pv(o,vb0+sl_cur,PAF(0),PAF(1),PAF(2),PAF(3)); }
  #undef PKW
  #undef PAF
  #undef VFR
  #undef PIN
  #undef MX3
  #undef GAPA
  #undef GAPB
  #undef EX
  #undef VRD
  #undef KRD
  #undef STEP
  #undef ENDW
  {auto rr=__builtin_amdgcn_permlane32_swap(__float_as_uint(l_reg),__float_as_uint(l_reg),false,false);l_reg=__uint_as_float(rr[0])+__uint_as_float(rr[1]);}
  if(hi==0)wsf[32+r32]=l_reg;asm volatile("s_waitcnt lgkmcnt(0)":::"memory");
  float rli[16];
  #pragma unroll
  for(int r=0;r<16;++r)rli[r]=__builtin_amdgcn_rcpf(wsf[32+crow(r,hi)]);
  bf16*Ow=O0+(long)(wid*QBLK)*PQ;
  { bf16*stg=(bf16*)(shm+LDS_OST)+wid*2048;
    #pragma unroll
    for(int r=0;r<16;++r){const int orow=crow(r,hi);
      #pragma unroll
      for(int d0=0;d0<2;++d0)stg[orow*64+d0*32+r32]=__float2bfloat16(o[d0][r]*rli[r]);}
    asm volatile("s_waitcnt lgkmcnt(0)":::"memory");
    #pragma unroll
    for(int i=0;i<4;++i){const int row=i*8+(lane>>3),ch=lane&7; const u32x4 v=*(const u32x4*)(stg+row*64+ch*8); ATTN_STORE16(Ow+(long)row*PQ+ch*8,v);} }
  asm volatile("s_waitcnt lgkmcnt(0)\n\ts_barrier":::"memory");
  #undef DMA_K
  #undef DMA_V
  #undef CMASK
  #undef START
  #undef RESC
  #undef ROT
  #undef TIX
  #undef BFILL
}

#undef SBAR
#undef WAIT_BAR
}

#define LAS __attribute__((address_space(3)))
typedef unsigned short bf16_t;
typedef pg8::f32x4 f32x4;
typedef pg8::u32x4 u32x4;
typedef attn_body::bf16 abf16;

constexpr int NB = 8, SEQ = 4096, DM = 1024, NTOK = NB * SEQ, DTOK = 768, NGRP = 48, DFF = 2816, MEMT = 256, NHEAD = 12;
constexpr float EPS = 1e-6f, LOG2E = 1.4426950408889634f, C2 = 0.125f * 1.4426950408889634f, INV2PI = 0.15915494309189535f;
constexpr int NTHREADS = 512, NWAVES = 8;
constexpr int LDS_BYTES = 147456;
constexpr int LDS_BTAB = 98304, LDS_WSUM = 114688;

constexpr size_t MiB = (size_t)1 << 20;
constexpr size_t WS_SS = 0;
constexpr size_t WS_LOGF = 1 * MiB;
constexpr size_t WS_KMAX = 3 * MiB + 65536;
constexpr size_t WS_BAR = 3 * MiB;
constexpr size_t WS_WIN0 = 4 * MiB, WS_WOUT0 = 6 * MiB, WS_WOUT1 = 8 * MiB, WS_WUP0 = 10 * MiB, WS_WUP1 = 21 * MiB;
constexpr size_t WS_WDN0 = 32 * MiB, WS_WDN1 = 38 * MiB, WS_WGLU = 44 * MiB, WS_WKVQ = 46 * MiB, WS_WMKV0 = 51 * MiB, WS_WMKV1 = 52 * MiB;
constexpr size_t WS_BT1 = 53 * MiB, WS_BT3 = 59 * MiB, WS_MEMN = 68 * MiB, WS_MEMKV0 = 72 * MiB, WS_MEMKV1 = 74 * MiB;
constexpr size_t WS_HB = 76 * MiB;
constexpr size_t WS_R = 140 * MiB;
constexpr size_t WS_PROJ0 = WS_R, WS_A3 = WS_R + 64 * MiB, WS_SLOC = WS_R + 136 * MiB, WS_GB = WS_R + 184 * MiB, WS_TOKMIX = WS_R + 232 * MiB;
constexpr size_t WS_ABUF = WS_R, WS_GBUF = WS_R + 176 * MiB;
constexpr size_t WS_KV = WS_R, WS_PROJ1 = WS_R + 96 * MiB;
constexpr size_t WS_END = WS_R + 352 * MiB;

__device__ __forceinline__ unsigned pk2(float lo, float hi) { return pg8::cvt_pk_bf16(lo, hi); }
__device__ __forceinline__ float bf_lo(unsigned w) { return __uint_as_float(w << 16); }
__device__ __forceinline__ float bf_hi(unsigned w) { return __uint_as_float(w & 0xffff0000u); }
__device__ __forceinline__ bf16_t f2bf(float f) { return (bf16_t)(pk2(f, 0.f) & 0xffffu); }
__device__ __forceinline__ float wave_sum(float v) {
#pragma unroll
    for (int o = 1; o < 64; o <<= 1) v += __shfl_xor(v, o);
    return v;
}
__device__ __forceinline__ float fexp(float x) { return __builtin_amdgcn_exp2f(x * LOG2E); }
__device__ __forceinline__ float frcp(float x) { return __builtin_amdgcn_rcpf(x); }
__device__ __forceinline__ float sigm(float x) { return frcp(1.f + fexp(-x)); }
__device__ __forceinline__ float gelu_tanh(float x) {
    const float z = 0.7978845608028654f * (x + 0.044715f * x * x * x);
    const float e = fexp(2.f * z);
    const float th = 1.f - 2.f * frcp(1.f + e);
    return 0.5f * x * (1.f + th);
}
__device__ __forceinline__ float rstd_of(float ss) { return __builtin_amdgcn_rsqf(ss * (1.f / 1024.f) + EPS); }
__device__ __forceinline__ void unpack8(const u32x4 w, float (&f)[8]) {
    f[0] = bf_lo(w.x); f[1] = bf_hi(w.x); f[2] = bf_lo(w.y); f[3] = bf_hi(w.y); f[4] = bf_lo(w.z); f[5] = bf_hi(w.z); f[6] = bf_lo(w.w); f[7] = bf_hi(w.w);
}
__device__ __forceinline__ u32x4 pack8(const float (&f)[8]) { u32x4 w; w.x = pk2(f[0], f[1]); w.y = pk2(f[2], f[3]); w.z = pk2(f[4], f[5]); w.w = pk2(f[6], f[7]); return w; }

#define LOAD_RS8(rs, ss) float rs[2][4]; { float t_[2][4]; _Pragma("unroll") for (int ai = 0; ai < 2; ++ai) _Pragma("unroll") for (int mm = 0; mm < 4; ++mm) t_[ai][mm] = (ss)[u.pm * 256 + ai * 128 + wr * 64 + mm * 16 + fr]; \
    _Pragma("unroll") for (int ai = 0; ai < 2; ++ai) _Pragma("unroll") for (int mm = 0; mm < 4; ++mm) rs[ai][mm] = rstd_of(t_[ai][mm]); }
#define EPI_ROWS(...) _Pragma("unroll") for (int ai = 0; ai < 2; ++ai) _Pragma("unroll") for (int m = 0; m < 4; ++m) { const int row = u.pm * 256 + ai * 128 + wr * 64 + m * 16 + fr; __VA_ARGS__ asm volatile("" ::: "memory"); }
typedef const f32x4 (&AccRef)[2][2][4][2];

struct EpiStore {
    static constexpr bool PERM = true, AFTER_DRAIN = false;
    const float* ss; bf16_t* o0; int ld0; int split; bf16_t* o1; int ld1;
    __device__ __forceinline__ void operator()(AccRef acc, const pg8::Unit& u, int wr, int wc, int fr, int fq) const {
        asm volatile("" : "+v"(fr), "+v"(fq));
        const int colt = u.pn * 256; bf16_t* base; int ld, cb;
        if (colt < split) { base = o0; ld = ld0; cb = colt; } else { base = o1; ld = ld1; cb = colt - split; }
        const int col0 = cb + wc * 32 + 8 * fq;
        float rsv[2][4];
        if (ss) { LOAD_RS8(r8, ss) _Pragma("unroll") for (int ai = 0; ai < 2; ++ai) _Pragma("unroll") for (int mm = 0; mm < 4; ++mm) rsv[ai][mm] = r8[ai][mm]; }
        else { _Pragma("unroll") for (int ai = 0; ai < 2; ++ai) _Pragma("unroll") for (int mm = 0; mm < 4; ++mm) rsv[ai][mm] = 1.f; }
        EPI_ROWS(
            const float rs = rsv[ai][m]; bf16_t* rp = base + (size_t)row * ld + col0;
            _Pragma("unroll") for (int bj = 0; bj < 2; ++bj) { const f32x4 v0 = acc[ai][bj][m][0] * rs, v1 = acc[ai][bj][m][1] * rs;
                u32x4 w; w.x = pk2(v0[0], v0[1]); w.y = pk2(v0[2], v0[3]); w.z = pk2(v1[0], v1[1]); w.w = pk2(v1[2], v1[3]); *(u32x4*)(rp + bj * 128) = w; }
        )
    }
};
struct EpiKVQ {
    static constexpr bool PERM = true, AFTER_DRAIN = false;
    const float* ss; bf16_t* kv; bf16_t* proj; unsigned* kmax;
    __device__ __forceinline__ void operator()(AccRef acc, const pg8::Unit& u, int wr, int wc, int fr, int fq) const {
        asm volatile("" : "+v"(fr), "+v"(fq));
        const bool isq = u.pn >= 6; bf16_t* base = isq ? proj : kv; const int ld = isq ? 1024 : 1536, col0 = (isq ? u.pn * 256 - 1536 : u.pn * 256) + wc * 32 + 8 * fq;
        LOAD_RS8(rsv, ss)
        float mx[2] = {0.f, 0.f};
        EPI_ROWS(
            const float rs = rsv[ai][m]; bf16_t* rp = base + (size_t)row * ld + col0;
            _Pragma("unroll") for (int bj = 0; bj < 2; ++bj) { const f32x4 v0 = acc[ai][bj][m][0] * rs, v1 = acc[ai][bj][m][1] * rs;
                u32x4 w; w.x = pk2(v0[0], v0[1]); w.y = pk2(v0[2], v0[3]); w.z = pk2(v1[0], v1[1]); w.w = pk2(v1[2], v1[3]); __builtin_nontemporal_store(w, (u32x4*)(rp + bj * 128));
                if (u.pn < 3) { float sq = (v0[0] * v0[0] + v0[1] * v0[1]) + (v0[2] * v0[2] + v0[3] * v0[3]) + (v1[0] * v1[0] + v1[1] * v1[1]) + (v1[2] * v1[2] + v1[3] * v1[3]);
                    sq += __shfl_xor(sq, 16); sq += __shfl_xor(sq, 32); mx[bj] = fmaxf(mx[bj], sq); } }
        )
        if (u.pn < 3) {
#pragma unroll
            for (int bj = 0; bj < 2; ++bj) { float v = mx[bj];
#pragma unroll
                for (int o = 1; o < 16; o <<= 1) v = fmaxf(v, __shfl_xor(v, o));
                if (fr == 0 && fq == 0) { const int b = (u.pm * 256) >> 12, h = u.pn * 4 + bj * 2 + (wc >> 1);
                    __hip_atomic_fetch_max(kmax + (b * NHEAD + h) * 2 + (wc & 1), __float_as_uint(v), __ATOMIC_RELAXED, __HIP_MEMORY_SCOPE_AGENT); } }
        }
    }
};
struct EpiIn0 {
    static constexpr bool PERM = true, AFTER_DRAIN = false;
    const float* ss; bf16_t* A3; bf16_t* proj;
    __device__ __forceinline__ void operator()(AccRef acc, const pg8::Unit& u, int wr, int wc, int fr, int fq) const {
        asm volatile("" : "+v"(fr), "+v"(fq));
        const int colt = u.pn * 256;
        LOAD_RS8(rsv, ss)
        EPI_ROWS(
            const float rs = rsv[ai][m];
            _Pragma("unroll") for (int bj = 0; bj < 2; ++bj) { const f32x4 v0 = acc[ai][bj][m][0] * rs, v1 = acc[ai][bj][m][1] * rs;
                u32x4 w; w.x = pk2(v0[0], v0[1]); w.y = pk2(v0[2], v0[3]); w.z = pk2(v1[0], v1[1]); w.w = pk2(v1[2], v1[3]);
                const int col = colt + bj * 128 + wc * 32 + 8 * fq;
                bf16_t* dst = (colt < DTOK) ? A3 + ((size_t)((col >> 4) * 2048 + (row >> 4)) * 384 + (row & 15) * 16 + (col & 15)) : proj + (size_t)row * 1024 + col;
                *(u32x4*)dst = w; }
        )
    }
};
struct EpiS1 {
    static constexpr bool PERM = true, AFTER_DRAIN = false;
    float* sloc;
    __device__ __forceinline__ void operator()(AccRef acc, const pg8::Unit& u, int wr, int wc, int fr, int fq) const {
        asm volatile("" : "+v"(fr), "+v"(fq));
        EPI_ROWS( float* p = sloc + (size_t)row * 128 + wc * 32 + 8 * fq; *(f32x4*)p = acc[ai][0][m][0]; *(f32x4*)(p + 4) = acc[ai][0][m][1]; )
    }
};
struct EpiS3 {
    static constexpr bool PERM = true, AFTER_DRAIN = false;
    bf16_t* gb;
    __device__ __forceinline__ void operator()(AccRef acc, const pg8::Unit& u, int wr, int wc, int fr, int fq) const {
        asm volatile("" : "+v"(fr), "+v"(fq));
        const int g = u.pn;
        EPI_ROWS(
            const int rl = row & 2047;
            _Pragma("unroll") for (int bj = 0; bj < 2; ++bj) { const int colL = bj * 128 + wc * 32 + 8 * fq, s = colL >> 4, i0 = colL & 15;
                const f32x4 a0 = acc[ai][bj][m][0], a1 = acc[ai][bj][m][1]; u32x4 w;
                w.x = pk2(gelu_tanh(a0[0]), gelu_tanh(a0[1])); w.y = pk2(gelu_tanh(a0[2]), gelu_tanh(a0[3]));
                w.z = pk2(gelu_tanh(a1[0]), gelu_tanh(a1[1])); w.w = pk2(gelu_tanh(a1[2]), gelu_tanh(a1[3]));
                *(u32x4*)(gb + (size_t)(rl * 16 + s) * DTOK + g * 16 + i0) = w; }
        )
    }
};
struct EpiGlu {
    static constexpr bool PERM = true, AFTER_DRAIN = false;
    const bf16_t* gb; bf16_t* tokmix;
    __device__ __forceinline__ void operator()(AccRef acc, const pg8::Unit& u, int wr, int wc, int fr, int fq) const {
        asm volatile("" : "+v"(fr), "+v"(fq));
#pragma unroll
        for (int ai = 0; ai < 2; ++ai) {
            u32x4 gw[4][2];
#pragma unroll
            for (int m = 0; m < 4; ++m)
#pragma unroll
                for (int bj = 0; bj < 2; ++bj) gw[m][bj] = *(const u32x4*)(gb + (size_t)(u.pm * 256 + ai * 128 + wr * 64 + m * 16 + fr) * DTOK + u.pn * 256 + bj * 128 + wc * 32 + 8 * fq);
#pragma unroll
            for (int m = 0; m < 4; ++m)
#pragma unroll
                for (int bj = 0; bj < 2; ++bj) { const int row = u.pm * 256 + ai * 128 + wr * 64 + m * 16 + fr, col0 = u.pn * 256 + bj * 128 + wc * 32 + 8 * fq;
                    float gf[8]; unpack8(gw[m][bj], gf); const f32x4 a0 = acc[ai][bj][m][0], a1 = acc[ai][bj][m][1]; float y[8];
#pragma unroll
                    for (int j = 0; j < 4; ++j) { y[j] = gf[j] * sigm(a0[j]); y[4 + j] = gf[4 + j] * sigm(a1[j]); }
                    *(u32x4*)(tokmix + (size_t)row * 1024 + col0) = pack8(y); }
            asm volatile("" ::: "memory");
        }
    }
};
template <bool BASE_BF16, bool WRITE_F32>
struct EpiRes {
    static constexpr bool PERM = true, AFTER_DRAIN = false;
    const void* base; float* out; bf16_t* hb; float* ss;
    __device__ __forceinline__ void operator()(AccRef acc, const pg8::Unit& u, int wr, int wc, int fr, int fq) const {
        asm volatile("" : "+v"(fr), "+v"(fq));
#pragma unroll
        for (int ai = 0; ai < 2; ++ai) {
            f32x4 bv[4][2][2];
#pragma unroll
            for (int m = 0; m < 4; ++m)
#pragma unroll
                for (int bj = 0; bj < 2; ++bj) { const size_t off = (size_t)(u.pm * 256 + ai * 128 + wr * 64 + m * 16 + fr) * 1024 + u.pn * 256 + bj * 128 + wc * 32 + 8 * fq;
                    if (BASE_BF16) { const u32x4 w = *(const u32x4*)((const bf16_t*)base + off);
                        bv[m][bj][0] = (f32x4){bf_lo(w.x), bf_hi(w.x), bf_lo(w.y), bf_hi(w.y)}; bv[m][bj][1] = (f32x4){bf_lo(w.z), bf_hi(w.z), bf_lo(w.w), bf_hi(w.w)}; }
                    else { bv[m][bj][0] = *(const f32x4*)((const float*)base + off); bv[m][bj][1] = *(const f32x4*)((const float*)base + off + 4); } }
#pragma unroll
            for (int m = 0; m < 4; ++m) { const int row = u.pm * 256 + ai * 128 + wr * 64 + m * 16 + fr; float sq = 0.f;
#pragma unroll
                for (int bj = 0; bj < 2; ++bj) { const size_t off = (size_t)row * 1024 + u.pn * 256 + bj * 128 + wc * 32 + 8 * fq;
                    const f32x4 v0 = acc[ai][bj][m][0] + bv[m][bj][0], v1 = acc[ai][bj][m][1] + bv[m][bj][1];
                    if (WRITE_F32) { *(f32x4*)(out + off) = v0; *(f32x4*)(out + off + 4) = v1; }
                    if (hb) { u32x4 w; w.x = pk2(v0[0], v0[1]); w.y = pk2(v0[2], v0[3]); w.z = pk2(v1[0], v1[1]); w.w = pk2(v1[2], v1[3]); *(u32x4*)(hb + off) = w; }
                    sq += (v0[0] * v0[0] + v0[1] * v0[1]) + (v0[2] * v0[2] + v0[3] * v0[3]) + (v1[0] * v1[0] + v1[1] * v1[1]) + (v1[2] * v1[2] + v1[3] * v1[3]); }
                sq += __shfl_xor(sq, 16); sq += __shfl_xor(sq, 32);
                if (fq == 0) __hip_atomic_fetch_add(ss + row, sq, __ATOMIC_RELAXED, __HIP_MEMORY_SCOPE_AGENT); }
            asm volatile("" ::: "memory");
        }
    }
};
typedef EpiRes<true, false> EpiResMix;
typedef EpiRes<true, true> EpiResFfn;
struct EpiUpConv {
    static constexpr bool PERM = true, AFTER_DRAIN = false;
    const float* ss; bf16_t* act; const float* cw; const float* cb; float* ghead; float* gtail;
    __device__ __forceinline__ void operator()(AccRef acc, const pg8::Unit& u, int wr, int wc, int fr, int fq) const {
        asm volatile("" : "+v"(fr), "+v"(fq));
        const int ch0 = u.pn * 128 + wc * 32 + 8 * fq, tok0 = u.pm * 256 + wr * 128 + fr * 8, grp = tok0 >> 7;
        const bool seq0 = (tok0 & (SEQ - 1)) == 0, head = (fr == 0) && !seq0;
        const f32x4 rsa = *(const f32x4*)(ss + tok0), rsb = *(const f32x4*)(ss + tok0 + 4);
        float rs[8];
#pragma unroll
        for (int k = 0; k < 4; ++k) { rs[k] = rstd_of(rsa[k]); rs[4 + k] = rstd_of(rsb[k]); }
        unsigned ylo[8][2];
#pragma unroll
        for (int n = 0; n < 2; ++n) {
            const int ch = ch0 + 4 * n;
            const f32x4 w0 = *(const f32x4*)(cw + ch), w1 = *(const f32x4*)(cw + DFF + ch), w2 = *(const f32x4*)(cw + 2 * DFF + ch), bb = *(const f32x4*)(cb + ch);
            const f32x4 g6 = acc[1][1][2][n] * rs[6], g7 = acc[1][1][3][n] * rs[7];
            f32x4 gm2, gm1;
#pragma unroll
            for (int j = 0; j < 4; ++j) { gm2[j] = __shfl_up(g6[j], 1); gm1[j] = __shfl_up(g7[j], 1); }
            if (seq0) { gm2 = (f32x4){0.f, 0.f, 0.f, 0.f}; gm1 = gm2; }
            if (fr == 15) { *(f32x4*)(gtail + ((size_t)grp * 2 + 0) * DFF + ch) = g6; *(f32x4*)(gtail + ((size_t)grp * 2 + 1) * DFF + ch) = g7; }
#pragma unroll
            for (int k = 0; k < 8; ++k) {
                const f32x4 gk = acc[k >> 2][1][k & 3][n] * rs[k], ak = acc[k >> 2][0][k & 3][n] * rs[k];
                const f32x4 part = (k == 1) ? (w1 * gm1 + w2 * gk + bb) : (w2 * gk + bb);
                if (k < 2 && head) { *(f32x4*)(ghead + ((size_t)grp * 4 + k) * DFF + ch) = part; *(f32x4*)(ghead + ((size_t)grp * 4 + 2 + k) * DFF + ch) = ak; }
                const f32x4 gc = (k == 1) ? (part + w0 * gm2) : (part + w0 * gm2 + w1 * gm1);
                const unsigned p0 = pk2(gc[0] * sigm(gc[0]) * ak[0], gc[1] * sigm(gc[1]) * ak[1]), p1 = pk2(gc[2] * sigm(gc[2]) * ak[2], gc[3] * sigm(gc[3]) * ak[3]);
                if (n == 0) { ylo[k][0] = p0; ylo[k][1] = p1; }
                else { u32x4 w; w.x = ylo[k][0]; w.y = ylo[k][1]; w.z = p0; w.w = p1; __builtin_nontemporal_store(w, (u32x4*)(act + (size_t)(tok0 + k) * DFF + ch0)); }
                gm2 = gm1; gm1 = gk;
            }
        }
    }
};
struct GroupOrder {
    int G, c;
    __device__ __forceinline__ bool next(int i, pg8::Unit& u) const { const int L = i * G + c; if (L >= NGRP * 8) return false; u.pm = L; u.pn = L >> 3; return true; }
    __device__ __forceinline__ void a_ready(const pg8::Unit&) const {}
    __device__ __forceinline__ void done(const pg8::Unit&) const {}
};

__device__ __forceinline__ void tr_item(const float* __restrict__ W, int K, int N, bf16_t* __restrict__ dst, const float* __restrict__ gk, int cs_from, int mode, int row_off,
                                        LAS float* scr, int item, int lane) {
    const int nblk = N / 64, kb = item / nblk, nb = item - kb * nblk, k0 = 32 * kb, n0 = 64 * nb;
    const int lk = lane >> 4, ln = (lane & 15) * 4;
    f32x4 v[8];
#pragma unroll
    for (int i = 0; i < 8; ++i) v[i] = *(const f32x4*)(W + (size_t)(k0 + 4 * i + lk) * N + n0 + ln);
    if (gk) {
#pragma unroll
        for (int i = 0; i < 8; ++i) v[i] = v[i] * gk[k0 + 4 * i + lk];
    }
#pragma unroll
    for (int i = 0; i < 8; ++i) { LAS float* s = scr + (4 * i + lk) * 65 + ln; s[0] = v[i][0]; s[1] = v[i][1]; s[2] = v[i][2]; s[3] = v[i][3]; }
    asm volatile("s_waitcnt lgkmcnt(0)" ::: "memory");
    const float csc = (n0 >= cs_from) ? C2 : 1.f;
    int drow0;
    if (mode == 1) { drow0 = (n0 < DFF) ? 256 * (n0 >> 7) + (n0 & 127) : 256 * ((n0 - DFF) >> 7) + 128 + ((n0 - DFF) & 127); } else drow0 = row_off + n0;
    const int c = lane & 3;
#pragma unroll
    for (int j = 0; j < 4; ++j) { const int n = (lane >> 2) + 16 * j; const LAS float* s = scr + (8 * c) * 65 + n;
        u32x4 o; o.x = pk2(s[0] * csc, s[65] * csc); o.y = pk2(s[130] * csc, s[195] * csc); o.z = pk2(s[260] * csc, s[325] * csc); o.w = pk2(s[390] * csc, s[455] * csc);
        *(u32x4*)(dst + (size_t)(drow0 + n) * K + k0 + 8 * c) = o; }
    asm volatile("s_waitcnt lgkmcnt(0)" ::: "memory");
}

__device__ __forceinline__ void s5_tables(const float* a_re, const float* a_im, const float* log_dt, const float* b_re, const float* b_im, const float* c_re, const float* c_im, const float* s5d,
                                          bf16_t* Bt1, bf16_t* Bt3, LAS float* L, int g, int part, int tid) {
    LAS float* Are = L; LAS float* Aim = L + 1088; LAS float* Bre = L + 2176; LAS float* Bim = L + 3200; LAS float* Cre = L + 4224; LAS float* Cim = L + 5248; LAS float* Kt = L + 6272;
    if (tid < 64) {
        const int p = tid; const float dt = fexp(log_dt[g]); const float lr = fminf(a_re[g * 64 + p], -1e-4f), li = a_im[g * 64 + p];
        for (int k = 0; k <= 16; ++k) { const float mag = fexp(lr * dt * (float)k); float rev = li * dt * (float)k * INV2PI; rev -= rintf(rev);
            Are[k * 64 + p] = mag * __builtin_amdgcn_cosf(rev); Aim[k * 64 + p] = mag * __builtin_amdgcn_sinf(rev); }
        const float abr = Are[64 + p], abi = Aim[64 + p], den = lr * lr + li * li;
        const float zr = ((abr - 1.f) * lr + abi * li) / den, zi = (abi * lr - (abr - 1.f) * li) / den;
        for (int j = 0; j < 16; ++j) { const float br = b_re[(g * 64 + p) * 16 + j], bi = b_im[(g * 64 + p) * 16 + j]; Bre[p * 16 + j] = zr * br - zi * bi; Bim[p * 16 + j] = zr * bi + zi * br; }
    }
    for (int e = tid; e < 1024; e += NTHREADS) { Cre[e] = c_re[g * 1024 + e]; Cim[e] = c_im[g * 1024 + e]; }
    __syncthreads();
    if (part == 0) {
    for (int q = 0; q < 8; ++q) { const int e = tid + NTHREADS * q, k = e >> 8, i = (e >> 4) & 15, j = e & 15; float acc = 0.f;
        for (int p = 0; p < 64; ++p) { const float ar = Are[k * 64 + p], ai = Aim[k * 64 + p], br = Bre[p * 16 + j], bi = Bim[p * 16 + j];
            acc += Cre[i * 64 + p] * (ar * br - ai * bi) - Cim[i * 64 + p] * (ar * bi + ai * br); }
        Kt[e] = acc; }
    __syncthreads();
    for (int idx = tid; idx < 256 * 256; idx += NTHREADS) { const int n = idx >> 8, k = idx & 255, s = n >> 4, i = n & 15, r = k >> 4, j = k & 15;
        float v = (s >= r) ? Kt[((s - r) * 16 + i) * 16 + j] : 0.f; if (s == r && i == j) v += s5d[g * 16 + i];
        Bt3[(size_t)(g * 256 + n) * 384 + k] = f2bf(v); }
    } else {
    for (int idx = tid; idx < 256 * 128; idx += NTHREADS) { const int n = idx >> 7, k = 256 + (idx & 127), s = n >> 4, i = n & 15; float v;
        if (k < 320) { const int p = k - 256; v = Cre[i * 64 + p] * Are[(s + 1) * 64 + p] - Cim[i * 64 + p] * Aim[(s + 1) * 64 + p]; }
        else { const int p = k - 320; v = -(Cre[i * 64 + p] * Aim[(s + 1) * 64 + p] + Cim[i * 64 + p] * Are[(s + 1) * 64 + p]); }
        Bt3[(size_t)(g * 256 + n) * 384 + k] = f2bf(v); }
    for (int idx = tid; idx < 65536; idx += NTHREADS) { const int n = idx >> 8, k = idx & 255, r = k >> 4, j = k & 15; float v = 0.f;
        if (n < 64) { const int p = n; v = Are[(15 - r) * 64 + p] * Bre[p * 16 + j] - Aim[(15 - r) * 64 + p] * Bim[p * 16 + j]; }
        else if (n < 128) { const int p = n - 64; v = Are[(15 - r) * 64 + p] * Bim[p * 16 + j] + Aim[(15 - r) * 64 + p] * Bre[p * 16 + j]; }
        Bt1[(size_t)(g * 256 + n) * 256 + k] = f2bf(v); }
    }
    __syncthreads();
}

__device__ __forceinline__ void s5_scan_item(const float* a_re, const float* a_im, const float* log_dt, const float* __restrict__ sloc, bf16_t* __restrict__ A3, int item, int lane) {
    const int g = item >> 3, b = item & 7, p = lane;
    const float dt = fexp(log_dt[g]); const float lr = fminf(a_re[g * 64 + p], -1e-4f), li = a_im[g * 64 + p];
    const float mag = fexp(lr * dt * 16.f); float rev = li * dt * 16.f * INV2PI; rev -= rintf(rev);
    const float ar = mag * __builtin_amdgcn_cosf(rev), ai = mag * __builtin_amdgcn_sinf(rev);
    float hr = 0.f, hi = 0.f; const size_t row0 = (size_t)g * 2048 + b * 256;
    float sr[16], si[16], nr[16], ni[16];
#define SCAN_LOAD(dr, di, c0) _Pragma("unroll") for (int q = 0; q < 16; ++q) { dr[q] = sloc[(row0 + (c0) + q) * 128 + p]; di[q] = sloc[(row0 + (c0) + q) * 128 + 64 + p]; }
#define SCAN_STEP(xr, xi, c0) _Pragma("unroll") for (int q = 0; q < 16; ++q) { bf16_t* a = A3 + (row0 + (c0) + q) * 384 + 256 + p; a[0] = f2bf(hr); a[64] = f2bf(hi); \
            const float t = ar * hr - ai * hi + xr[q]; hi = ar * hi + ai * hr + xi[q]; hr = t; }
    SCAN_LOAD(sr, si, 0)
#pragma unroll 1
    for (int c0 = 0; c0 < 256; c0 += 32) {
        SCAN_LOAD(nr, ni, c0 + 16)
        SCAN_STEP(sr, si, c0)
        if (c0 + 32 < 256) { SCAN_LOAD(sr, si, c0 + 32) }
        SCAN_STEP(nr, ni, c0 + 16)
    }
#undef SCAN_LOAD
#undef SCAN_STEP
}

__device__ __forceinline__ void convfix_panel(bf16_t* __restrict__ act, const float* __restrict__ ghead, const float* __restrict__ gtail, const float* __restrict__ cw, int pm, int tid) {
    for (int idx = tid; idx < 2 * 352; idx += NTHREADS) {
        const int grp = 2 * pm + idx / 352, ch = (idx % 352) * 8;
        if ((grp & 31) == 0) continue;
        unsigned o0[4], o1[4];
#pragma unroll
        for (int hh = 0; hh < 2; ++hh) { const int c = ch + 4 * hh;
            const f32x4 P0 = *(const f32x4*)(ghead + ((size_t)grp * 4 + 0) * DFF + c), P1 = *(const f32x4*)(ghead + ((size_t)grp * 4 + 1) * DFF + c);
            const f32x4 a0 = *(const f32x4*)(ghead + ((size_t)grp * 4 + 2) * DFF + c), a1 = *(const f32x4*)(ghead + ((size_t)grp * 4 + 3) * DFF + c);
            const f32x4 T6 = *(const f32x4*)(gtail + ((size_t)(grp - 1) * 2 + 0) * DFF + c), T7 = *(const f32x4*)(gtail + ((size_t)(grp - 1) * 2 + 1) * DFF + c);
            const f32x4 w0 = *(const f32x4*)(cw + c), w1 = *(const f32x4*)(cw + DFF + c);
            const f32x4 c0 = P0 + w0 * T6 + w1 * T7, c1 = P1 + w0 * T7;
            o0[2 * hh] = pk2(c0[0] * sigm(c0[0]) * a0[0], c0[1] * sigm(c0[1]) * a0[1]); o0[2 * hh + 1] = pk2(c0[2] * sigm(c0[2]) * a0[2], c0[3] * sigm(c0[3]) * a0[3]);
            o1[2 * hh] = pk2(c1[0] * sigm(c1[0]) * a1[0], c1[1] * sigm(c1[1]) * a1[1]); o1[2 * hh + 1] = pk2(c1[2] * sigm(c1[2]) * a1[2], c1[3] * sigm(c1[3]) * a1[3]); }
        u32x4 w; w.x = o0[0]; w.y = o0[1]; w.z = o0[2]; w.w = o0[3]; *(u32x4*)(act + (size_t)(grp * 128) * DFF + ch) = w;
        w.x = o1[0]; w.y = o1[1]; w.z = o1[2]; w.w = o1[3]; *(u32x4*)(act + (size_t)(grp * 128 + 1) * DFF + ch) = w;
    }
}

__device__ __forceinline__ void fgate_phase(const bf16_t* __restrict__ h, const float* __restrict__ ss, const float* __restrict__ wf, const float* __restrict__ gkv, const float* __restrict__ bfg,
                                            float* __restrict__ logf, LAS float* L, int tid, int wid, int lane) {
#pragma unroll 4
    for (int rec = tid; rec < 1024; rec += NTHREADS) { const int k = 256 * (rec >> 8) + 4 * (rec & 63) + ((rec >> 6) & 3); const float gk = gkv[k];
        const f32x4 a = *(const f32x4*)(wf + k * 12), b = *(const f32x4*)(wf + k * 12 + 4), c = *(const f32x4*)(wf + k * 12 + 8);
        LAS f32x4* d = (LAS f32x4*)(L + rec * 12); d[0] = a * gk; d[1] = b * gk; d[2] = c * gk; }
    __syncthreads();
    const LAS f32x4* L4 = (const LAS f32x4*)L;
    typedef unsigned u32x2_t __attribute__((ext_vector_type(2)));
    const int rstep = gridDim.x * NWAVES * 2; int r0 = (blockIdx.x * NWAVES + wid) * 2;
    u32x2_t hw[2][4], hn[2][4];
    { const int rc = r0 < NTOK ? r0 : 0;
#pragma unroll
      for (int r = 0; r < 2; ++r)
#pragma unroll
          for (int i = 0; i < 4; ++i) hw[r][i] = *(const u32x2_t*)(h + (size_t)(rc + r) * 1024 + 256 * i + 4 * lane); }
#pragma unroll 1
    for (; r0 < NTOK; r0 += rstep) {
        { const int rn = r0 + rstep < NTOK ? r0 + rstep : r0;
#pragma unroll
          for (int r = 0; r < 2; ++r)
#pragma unroll
              for (int i = 0; i < 4; ++i) hn[r][i] = *(const u32x2_t*)(h + (size_t)(rn + r) * 1024 + 256 * i + 4 * lane); }
        f32x4 hv[2][4];
#pragma unroll
        for (int r = 0; r < 2; ++r)
#pragma unroll
            for (int i = 0; i < 4; ++i) hv[r][i] = (f32x4){bf_lo(hw[r][i].x), bf_hi(hw[r][i].x), bf_lo(hw[r][i].y), bf_hi(hw[r][i].y)};
        float acc[2][12];
#pragma unroll
        for (int r = 0; r < 2; ++r)
#pragma unroll
            for (int q = 0; q < 12; ++q) acc[r][q] = 0.f;
#pragma unroll
        for (int i = 0; i < 4; ++i)
#pragma unroll
            for (int e = 0; e < 4; ++e) { const int rec = (i * 4 + e) * 64 + lane; const f32x4 wa = L4[rec * 3], wb = L4[rec * 3 + 1], wc4 = L4[rec * 3 + 2];
#pragma unroll
                for (int r = 0; r < 2; ++r) { const float x = hv[r][i][e];
                    acc[r][0] += x * wa[0]; acc[r][1] += x * wa[1]; acc[r][2] += x * wa[2]; acc[r][3] += x * wa[3];
                    acc[r][4] += x * wb[0]; acc[r][5] += x * wb[1]; acc[r][6] += x * wb[2]; acc[r][7] += x * wb[3];
                    acc[r][8] += x * wc4[0]; acc[r][9] += x * wc4[1]; acc[r][10] += x * wc4[2]; acc[r][11] += x * wc4[3]; }
                if ((e & 1) == 1) __builtin_amdgcn_sched_barrier(0); }
        float z = 0.f;
#pragma unroll
        for (int r = 0; r < 2; ++r)
#pragma unroll
            for (int q = 0; q < 12; ++q) { const float v = wave_sum(acc[r][q]); if (lane == r * 12 + q) z = v; }
        if (lane < 24) { const int r = lane / 12, q = lane - r * 12, row = r0 + r;
            z = z * rstd_of(ss[row]) + bfg[q];
            const float lf = fminf(z, 0.f) - __logf(1.f + fexp(-fabsf(z)));
            logf[(size_t)((row >> 12) * NHEAD + q) * SEQ + (row & (SEQ - 1))] = lf; }
#pragma unroll
        for (int r = 0; r < 2; ++r)
#pragma unroll
            for (int i = 0; i < 4; ++i) hw[r][i] = hn[r][i];
    }
    __syncthreads();
}

__device__ __forceinline__ void build_btab(const float* __restrict__ lf, LAS float* btab, LAS float* wsum, int tid, int wid, int lane) {
    __syncthreads();
    const f32x4 a = *(const f32x4*)(lf + 8 * tid), b = *(const f32x4*)(lf + 8 * tid + 4);
    float p[8]; p[0] = a[0]; p[1] = p[0] + a[1]; p[2] = p[1] + a[2]; p[3] = p[2] + a[3]; p[4] = p[3] + b[0]; p[5] = p[4] + b[1]; p[6] = p[5] + b[2]; p[7] = p[6] + b[3];
    float x = p[7];
#pragma unroll
    for (int o = 1; o < 64; o <<= 1) { const float n = __shfl_up(x, o); if (lane >= o) x += n; }
    if (lane == 63) wsum[wid] = x;
    __syncthreads();
    float off = x - p[7];
    for (int w = 0; w < wid; ++w) off += wsum[w];
    f32x4 o0, o1;
    o0[0] = -(off + p[0]) * LOG2E; o0[1] = -(off + p[1]) * LOG2E; o0[2] = -(off + p[2]) * LOG2E; o0[3] = -(off + p[3]) * LOG2E;
    o1[0] = -(off + p[4]) * LOG2E; o1[1] = -(off + p[5]) * LOG2E; o1[2] = -(off + p[6]) * LOG2E; o1[3] = -(off + p[7]) * LOG2E;
    *(LAS f32x4*)(btab + 8 * tid) = o0; *(LAS f32x4*)(btab + 8 * tid + 4) = o1;
    __syncthreads();
}

__device__ __forceinline__ void mem_attn_phase(const bf16_t* proj, const bf16_t* memkv, bf16_t* tokmix, char* lds, int n_light, int lu) {
    const int NU = NB * 4 * 16, G = gridDim.x, bx = blockIdx.x;
    int u0, u1, ust;
    if (n_light > 0 && n_light < G && n_light * lu < NU) { const int nl = n_light * lu, per = (NU - nl + (G - n_light) - 1) / (G - n_light);
        if (bx < n_light) { u0 = bx * lu; u1 = u0 + lu; } else { u0 = nl + (bx - n_light) * per; u1 = u0 + per < NU ? u0 + per : NU; } ust = 1; }
    else { u0 = bx; u1 = NU; ust = G; }
    for (int ui = u0; ui < u1; ui += ust) {
        const int b = ui >> 6, h = (ui >> 4) & 3, qb = ui & 15;
        const size_t qoff = (size_t)(b * SEQ + qb * 256) * 1024 + DTOK + h * 64;
        const bf16_t* K = memkv + (size_t)(b * MEMT) * 512 + h * 64;
        attn_body::attn_unit<8, false, false, 1024, 512>((const abf16*)(proj + qoff), (const abf16*)K, (const abf16*)(K + 256), (abf16*)(tokmix + qoff), 4, (attn_body::lds_f4p)nullptr, lds);
    }
}
__device__ __forceinline__ void fox_attn_phase(const bf16_t* proj, const bf16_t* kv, bf16_t* tokmix, const float* logf, const unsigned* kmax, unsigned* ctr, char* lds, LAS unsigned char* ldsl, int tid, int wid, int lane) {
    int last_bh = -1;
    LAS float* btab = (LAS float*)(ldsl + LDS_BTAB); LAS float* wsum = (LAS float*)(ldsl + LDS_WSUM); volatile LAS unsigned* nxt = (volatile LAS unsigned*)(ldsl + LDS_WSUM + 128);
#pragma unroll 1
    for (;;) {
        __syncthreads();
        if (tid == 0) nxt[0] = __hip_atomic_fetch_add(ctr, 1u, __ATOMIC_RELAXED, __HIP_MEMORY_SCOPE_AGENT);
        __syncthreads();
        const int ui = (int)nxt[0];
        if (ui >= NB * NHEAD * 16) break;
        const int qb = 15 - ui / (NB * NHEAD), bh = ui % (NB * NHEAD), b = bh / NHEAD, h = bh - b * NHEAD;
        if (bh != last_bh) { build_btab(logf + (size_t)bh * SEQ, btab, wsum, tid, wid, lane); last_bh = bh; }
        const bf16_t* K = kv + (size_t)(b * SEQ) * 1536 + h * 64;
        const size_t qoff = (size_t)(b * SEQ + qb * 256) * 1024 + h * 64;
        const float kmv = 1.01f * sqrtf(__uint_as_float(kmax[bh * 2]) + __uint_as_float(kmax[bh * 2 + 1]));
        attn_body::attn_unit<8, true, true, 1024, 1536, true, true>((const abf16*)(proj + qoff), (const abf16*)K, (const abf16*)(K + DTOK), (abf16*)(tokmix + qoff), 4 * qb + 4, (attn_body::lds_f4p)btab, lds, kmv, (LAS float*)(ldsl + LDS_WSUM + 64));
    }
}

#define XB_TMO      128
#define XB_XCNT(j)  (256  + 64 * (j))
#define XB_XSUB(j)  (1280 + 64 * (j))
#define XB_XGEN(j)  (2304 + 64 * (j))
#define XB_TOP      3328
#define XB_TOPGEN   3392
#define XCD_BAR_WORDS 3456
#define XB_SPIN_CAP (1u << 18)

__device__ __forceinline__ unsigned xb_ld(unsigned* p)              { return __hip_atomic_load(p, __ATOMIC_RELAXED, __HIP_MEMORY_SCOPE_AGENT); }
__device__ __forceinline__ unsigned xb_add(unsigned* p, unsigned v) { return __hip_atomic_fetch_add(p, v, __ATOMIC_RELAXED, __HIP_MEMORY_SCOPE_AGENT); }
__device__ __forceinline__ unsigned xb_xcc_id() { return (unsigned)__builtin_amdgcn_s_getreg((3 << 11) | 20) & 0xFu; }
#define XB_SPIN(cond, bar) do { unsigned _sp = 0; while (cond) { __builtin_amdgcn_s_sleep(1); \
    if ((++_sp & 255u) == 0u) { if (xb_ld(&(bar)[XB_TMO])) break; if (_sp > XB_SPIN_CAP) { atomicAdd(&(bar)[XB_TMO], 1u); break; } } } } while (0)

struct XcdBarrier {
    unsigned* bar; unsigned x;
    volatile LAS unsigned* st;
};

__device__ __forceinline__ XcdBarrier xcd_barrier_post(unsigned* bar, volatile LAS unsigned* st) {
    XcdBarrier b; b.bar = bar; b.x = xb_xcc_id(); b.st = st;
    if (threadIdx.x == 0) (void)xb_add(&bar[XB_XCNT(b.x)], 1u);
    return b;
}
__device__ __forceinline__ void xcd_barrier_complete(unsigned* bar, unsigned x, unsigned& nloc, unsigned& nx) {
    const unsigned G = gridDim.x * gridDim.y * gridDim.z;
    unsigned sum, cnt, mine, sp = 0u;
    for (;;) {
        sum = 0u; cnt = 0u; mine = 0u;
#pragma unroll
        for (unsigned j = 0; j < 16; ++j) { const unsigned c = xb_ld(&bar[XB_XCNT(j)]); sum += c; cnt += (c > 0u) ? 1u : 0u; mine = (j == x) ? c : mine; }
        if (sum == G) break;
        __builtin_amdgcn_s_sleep(1);
        if ((++sp & 255u) == 0u) { if (xb_ld(&bar[XB_TMO])) break; if (sp > XB_SPIN_CAP) { atomicAdd(&bar[XB_TMO], 1u); break; } }
    }
    nloc = mine > 0u ? mine : 1u; nx = cnt > 0u ? cnt : 1u;
}

__device__ __forceinline__ void xcd_barrier(const XcdBarrier& b) {
    asm volatile("s_waitcnt vmcnt(0)" ::: "memory");
    __syncthreads();
    if (threadIdx.x == 0) {
        unsigned* bar = b.bar;
        __builtin_amdgcn_s_waitcnt(0);
        unsigned nloc = b.st[0], nx = b.st[1];
        if (nloc == 0u) { xcd_barrier_complete(bar, b.x, nloc, nx); b.st[0] = nloc; b.st[1] = nx; }
        const unsigned old = xb_add(&bar[XB_XSUB(b.x)], 1u);
        const unsigned gen = old / nloc;
        if (old + 1u == (gen + 1u) * nloc) {
            __builtin_amdgcn_fence(__ATOMIC_RELEASE, "agent");
            asm volatile("s_waitcnt vmcnt(0)" ::: "memory");
            const unsigned og = xb_add(&bar[XB_TOP], 1u);
            const unsigned tg = og / nx;
            if (og + 1u == (tg + 1u) * nx) xb_add(&bar[XB_TOPGEN], 1u);
            else XB_SPIN(xb_ld(&bar[XB_TOPGEN]) == tg, bar);
            __builtin_amdgcn_fence(__ATOMIC_ACQUIRE, "agent");
            xb_add(&bar[XB_XGEN(b.x)], 1u);
            asm volatile("s_waitcnt vmcnt(0)" ::: "memory");
        } else {
            XB_SPIN(xb_ld(&bar[XB_XGEN(b.x)]) == gen, bar);
            __builtin_amdgcn_fence(__ATOMIC_ACQUIRE, "agent");
            asm volatile("s_waitcnt vmcnt(0)" ::: "memory");
        }
    }
    __syncthreads();
}

struct Args { const float* in[26]; float* out; unsigned char* ws; };
#define GEMM_CALL(EpiT, OrdT, g, S, E) pg8::gemm_phase<EpiT, OrdT, true, true>(ldsl, g, S, E)

__global__ void __launch_bounds__(NTHREADS, 2) fwd_megakernel(Args a) {
    extern __shared__ __attribute__((aligned(16))) unsigned char lds[];
    cg::grid_group grid = cg::this_grid();
    LAS unsigned char* ldsl = (LAS unsigned char*)lds;
#define TIDS() int tid_o = threadIdx.x; asm volatile("" : "+v"(tid_o)); const int tid = tid_o, lane = tid & 63, wid = __builtin_amdgcn_readfirstlane(tid >> 6); (void)lane; (void)wid
    const int G = gridDim.x, bx = blockIdx.x;
    unsigned* barw = (unsigned*)(a.ws + WS_BAR); volatile LAS unsigned* bst = (volatile LAS unsigned*)(ldsl + LDS_BYTES - 64);
    if (threadIdx.x < 2) bst[threadIdx.x] = 0u;
    unsigned char* ws = a.ws;
    const float* x = a.in[0]; float* out = a.out;
    float* ss = (float*)(ws + WS_SS); float* logf = (float*)(ws + WS_LOGF); unsigned* kmaxp = (unsigned*)(ws + WS_KMAX);
    bf16_t* hb = (bf16_t*)(ws + WS_HB);
    bf16_t* WIN0 = (bf16_t*)(ws + WS_WIN0); bf16_t* WGLU = (bf16_t*)(ws + WS_WGLU); bf16_t* WKVQ = (bf16_t*)(ws + WS_WKVQ);
    bf16_t* BT1 = (bf16_t*)(ws + WS_BT1); bf16_t* BT3 = (bf16_t*)(ws + WS_BT3); bf16_t* memn = (bf16_t*)(ws + WS_MEMN);
    bf16_t* A3 = (bf16_t*)(ws + WS_A3); float* sloc = (float*)(ws + WS_SLOC); bf16_t* gb = (bf16_t*)(ws + WS_GB); bf16_t* tokmix = (bf16_t*)(ws + WS_TOKMIX);
    bf16_t* abuf = (bf16_t*)(ws + WS_ABUF); float* ghead = (float*)(ws + WS_GBUF); float* gtail = (float*)(ws + WS_GBUF + 16 * MiB); bf16_t* kvb = (bf16_t*)(ws + WS_KV);
    bf16_t* proj0 = (bf16_t*)(ws + WS_PROJ0); bf16_t* proj1 = (bf16_t*)(ws + WS_PROJ1);

    constexpr int I_SQ = 16 * 32, I_UP = 16 * 176, I_DN = 44 * 32, I_GLU = 12 * 24, I_KV = 16 * 48, I_MKV = 16 * 16, BIG = 1 << 30, NTB = 2 * NGRP;
    {
        TIDS();
        if (bx == 0) for (int i = tid; i < XCD_BAR_WORDS; i += NTHREADS) barw[i] = 0u;
        if (bx == 0 && tid < NB * NHEAD * 2) kmaxp[tid] = 0u;
        if (bx == 0 && tid == 0) kmaxp[1024] = 0u;
        const bool split = G > NTB;
        for (int tb = bx; tb < NTB; tb += G) s5_tables(a.in[7], a.in[8], a.in[9], a.in[10], a.in[11], a.in[12], a.in[13], a.in[14], BT1, BT3, (LAS float*)ldsl, tb >> 1, tb & 1, tid);
        if (!split || bx >= NTB) {
            LAS float* scr = (LAS float*)(ldsl + wid * 16384);
            const int gw = (split ? bx - NTB : bx) * NWAVES + wid, NGW = (split ? G - NTB : G) * NWAVES;
            for (int it = gw; it < I_SQ + 2 * I_MKV; it += NGW) {
                int r = it;
                if (r < I_SQ) { tr_item(a.in[3], 1024, 1024, WIN0, a.in[2], DTOK, 0, 0, scr, r, lane); continue; } r -= I_SQ;
                if (r < I_MKV) { tr_item(a.in[6], 1024, 512, (bf16_t*)(ws + WS_WMKV0), nullptr, BIG, 0, 0, scr, r, lane); continue; } r -= I_MKV;
                tr_item(a.in[6] + 1024 * 512, 1024, 512, (bf16_t*)(ws + WS_WMKV1), nullptr, BIG, 0, 0, scr, r, lane);
            }
#pragma unroll 1
            for (int m = gw * 4; m < NTOK; m += NGW * 4) {
                const f32x4* xr = (const f32x4*)(x + (size_t)m * 1024) + lane; f32x4 v[16]; float s4[4];
#pragma unroll
                for (int j = 0; j < 16; ++j) v[j] = xr[64 * j];
#pragma unroll
                for (int r = 0; r < 4; ++r) { float s = 0.f;
#pragma unroll
                    for (int j = 0; j < 4; ++j) { const f32x4 t = v[4 * r + j]; s += (t[0] * t[0] + t[1] * t[1]) + (t[2] * t[2] + t[3] * t[3]); }
                    s4[r] = wave_sum(s); }
                if (lane == 0) { ss[m] = s4[0]; ss[m + 1] = s4[1]; ss[m + 2] = s4[2]; ss[m + 3] = s4[3]; }
                unsigned long long* o8 = (unsigned long long*)(hb + (size_t)m * 1024) + lane;
#pragma unroll
                for (int j = 0; j < 16; ++j) o8[64 * j] = (unsigned long long)pk2(v[j][0], v[j][1]) | ((unsigned long long)pk2(v[j][2], v[j][3]) << 32);
            }
            for (int m = gw; m < NB * MEMT; m += NGW) {
                const f32x4* xr = (const f32x4*)(a.in[1] + (size_t)m * 1024) + lane; const f32x4* gr = (const f32x4*)a.in[5] + lane; f32x4 v[4]; float s = 0.f;
#pragma unroll
                for (int j = 0; j < 4; ++j) { v[j] = xr[64 * j]; s += (v[j][0] * v[j][0] + v[j][1] * v[j][1]) + (v[j][2] * v[j][2] + v[j][3] * v[j][3]); }
                const float rs = rstd_of(wave_sum(s));
                unsigned long long* o8 = (unsigned long long*)(memn + (size_t)m * 1024) + lane;
#pragma unroll
                for (int j = 0; j < 4; ++j) { const f32x4 gg = gr[64 * j]; o8[64 * j] = (unsigned long long)pk2(v[j][0] * rs * gg[0], v[j][1] * rs * gg[1]) | ((unsigned long long)pk2(v[j][2] * rs * gg[2], v[j][3] * rs * gg[3]) << 32); }
            }
            for (int i = gw * 64 + lane; i < 4 * NTOK; i += NGW * 64) ss[NTOK + i] = 0.f;
        }
    }
    grid.sync();
    const XcdBarrier xbar = xcd_barrier_post(barw, bst);
#define SEAM() xcd_barrier(xbar)

    {
        pg8::Gemm g{hb, WIN0, NTOK, 1024, 1024, 1024, 1024}; pg8::StaticOrder S; S.init(NTOK, 1024, G, bx);
        EpiIn0 E{ss, A3, proj0}; GEMM_CALL(EpiIn0, pg8::StaticOrder, g, S, E);
    }
    SEAM();
    {
        GroupOrder S{G, bx};
        { pg8::Gemm g{A3, BT1, NGRP * 2048, NGRP * 256, 256, 384, 256}; EpiS1 E{sloc}; GEMM_CALL(EpiS1, GroupOrder, g, S, E); }
        asm volatile("s_waitcnt vmcnt(0)" ::: "memory"); __syncthreads(); __builtin_amdgcn_fence(__ATOMIC_ACQUIRE, "agent");
        {
            TIDS();
            if (wid < 2) { for (int item = wid * G + bx; item < NGRP * NB; item += G * 2) s5_scan_item(a.in[7], a.in[8], a.in[9], sloc, A3, item, lane); }
        else {
            LAS float* scr = (LAS float*)(ldsl + wid * 16384);
            constexpr int NLATE = 3 * I_SQ + 2 * I_UP + 2 * I_DN + I_GLU + I_KV;
            const int n2 = (NGRP * NB > G) ? ((NGRP * NB - G < G) ? NGRP * NB - G : G) : 0;
            const int nslots = 6 * n2 + 12 * (G - n2), slot0 = (bx < n2) ? 6 * bx + (wid - 2) : 6 * n2 + 12 * (bx - n2) + (wid - 2), nmine = (bx < n2) ? 1 : 2;
            for (int sl = 0; sl < nmine; ++sl)
            for (int it = slot0 + 6 * sl; it < NLATE; it += nslots) {
                int r = it;
                if (r < I_GLU) { tr_item(a.in[15], DTOK, DTOK, WGLU, nullptr, BIG, 0, 0, scr, r, lane); continue; } r -= I_GLU;
                if (r < I_SQ) { tr_item(a.in[4], 1024, 1024, (bf16_t*)(ws + WS_WOUT0), nullptr, BIG, 0, 0, scr, r, lane); continue; } r -= I_SQ;
                if (r < I_UP) { tr_item(a.in[21], 1024, 2 * DFF, (bf16_t*)(ws + WS_WUP0), a.in[20], BIG, 1, 0, scr, r, lane); continue; } r -= I_UP;
                if (r < I_DN) { tr_item(a.in[24], DFF, 1024, (bf16_t*)(ws + WS_WDN0), nullptr, BIG, 0, 0, scr, r, lane); continue; } r -= I_DN;
                if (r < I_KV) { tr_item(a.in[17], 1024, 1536, WKVQ, a.in[16], BIG, 0, 0, scr, r, lane); continue; } r -= I_KV;
                if (r < I_SQ) { tr_item(a.in[3] + 1024 * 1024, 1024, 1024, WKVQ, a.in[2] + 1024, 0, 0, 1536, scr, r, lane); continue; } r -= I_SQ;
                if (r < I_SQ) { tr_item(a.in[4] + 1024 * 1024, 1024, 1024, (bf16_t*)(ws + WS_WOUT1), nullptr, BIG, 0, 0, scr, r, lane); continue; } r -= I_SQ;
                if (r < I_UP) { tr_item(a.in[21] + (size_t)1024 * 2 * DFF, 1024, 2 * DFF, (bf16_t*)(ws + WS_WUP1), a.in[20] + 1024, BIG, 1, 0, scr, r, lane); continue; } r -= I_UP;
                tr_item(a.in[24] + (size_t)DFF * 1024, DFF, 1024, (bf16_t*)(ws + WS_WDN1), nullptr, BIG, 0, 0, scr, r, lane);
            }
        }
        }
        asm volatile("s_waitcnt vmcnt(0)" ::: "memory"); __syncthreads(); __builtin_amdgcn_fence(__ATOMIC_ACQUIRE, "agent");
        { pg8::Gemm g{A3, BT3, NGRP * 2048, NGRP * 256, 384, 384, 384}; EpiS3 E{gb}; GEMM_CALL(EpiS3, GroupOrder, g, S, E); }
        { const int n2 = (NGRP * NB > G && NGRP * NB - G < G) ? NGRP * NB - G : 0;
          pg8::Gemm g2{memn, (const bf16_t*)(ws + WS_WMKV0), NB * MEMT, 1024, 1024, 1024, 1024}; pg8::StaticOrder S2;
          if (G - n2 >= 32) S2.init(NB * MEMT, 1024, 1 << 20, bx >= n2 ? bx - n2 : 1 << 20); else S2.init(NB * MEMT, 1024, G, bx);
          EpiStore E2{nullptr, (bf16_t*)(ws + WS_MEMKV0), 512, 512, (bf16_t*)(ws + WS_MEMKV1), 512}; GEMM_CALL(EpiStore, pg8::StaticOrder, g2, S2, E2); }
    }
    SEAM();
    { pg8::Gemm g{gb, WGLU, NTOK, DTOK, DTOK, DTOK, DTOK}; pg8::StaticOrder S; S.init(NTOK, DTOK, G, bx); EpiGlu E{gb, tokmix}; GEMM_CALL(EpiGlu, pg8::StaticOrder, g, S, E); }
    { const int nglu = (NTOK / 256) * 3; mem_attn_phase(proj0, (const bf16_t*)(ws + WS_MEMKV0), tokmix, (char*)lds, (nglu > G && nglu - G < G) ? nglu - G : 0, 0); }
    SEAM();
    {   constexpr int l = 0;
        { pg8::Gemm g{tokmix, (const bf16_t*)(ws + (l ? WS_WOUT1 : WS_WOUT0)), NTOK, 1024, 1024, 1024, 1024}; pg8::StaticOrder S; S.init(NTOK, 1024, G, bx);
          EpiResMix E{(const void*)hb, out, hb, ss + (l ? 3 : 1) * NTOK}; GEMM_CALL(EpiResMix, pg8::StaticOrder, g, S, E); }
        SEAM();
        { pg8::Gemm g{hb, (const bf16_t*)(ws + (l ? WS_WUP1 : WS_WUP0)), NTOK, 2 * DFF, 1024, 1024, 1024}; pg8::StaticOrder S; S.init(NTOK, 2 * DFF, G, bx);
          EpiUpConv E{ss + (l ? 3 : 1) * NTOK, abuf, a.in[22] + l * 3 * DFF, a.in[23] + l * DFF, ghead, gtail};
          pg8::gemm_phase<EpiUpConv, pg8::StaticOrder, true, true, 1>(ldsl, g, S, E); }
        SEAM();
        { pg8::Gemm g{abuf, (const bf16_t*)(ws + (l ? WS_WDN1 : WS_WDN0)), NTOK, 1024, DFF, DFF, DFF}; pg8::StaticOrder S; S.init(NTOK, 1024, G, bx);
          { TIDS(); pg8::Unit uu; for (int i = 0; S.next(i, uu); ++i) convfix_panel(abuf, ghead, gtail, a.in[22] + l * 3 * DFF, uu.pm, tid); }
          asm volatile("s_waitcnt vmcnt(0)" ::: "memory"); __syncthreads();
          EpiResMix E{(const void*)hb, out, hb, ss + 2 * NTOK}; GEMM_CALL(EpiResMix, pg8::StaticOrder, g, S, E); }
        SEAM();
    }
    {
            { TIDS(); fgate_phase(hb, ss + 2 * NTOK, a.in[18], a.in[16], a.in[19], logf, (LAS float*)ldsl, tid, wid, lane); }
            { pg8::Gemm g{hb, WKVQ, NTOK, 2560, 1024, 1024, 1024}; pg8::StaticOrder S; S.init(NTOK, 2560, G, bx);
              EpiKVQ E{ss + 2 * NTOK, kvb, proj1, kmaxp}; GEMM_CALL(EpiKVQ, pg8::StaticOrder, g, S, E); }
            SEAM();
            { TIDS(); fox_attn_phase(proj1, kvb, tokmix, logf, kmaxp, kmaxp + 1024, (char*)lds, ldsl, tid, wid, lane); }
            mem_attn_phase(proj1, (const bf16_t*)(ws + WS_MEMKV1), tokmix, (char*)lds, 0, 1);
            SEAM();
    }
    {   constexpr int l = 1;
        { pg8::Gemm g{tokmix, (const bf16_t*)(ws + (l ? WS_WOUT1 : WS_WOUT0)), NTOK, 1024, 1024, 1024, 1024}; pg8::StaticOrder S; S.init(NTOK, 1024, G, bx);
          EpiResMix E{(const void*)hb, out, hb, ss + (l ? 3 : 1) * NTOK}; GEMM_CALL(EpiResMix, pg8::StaticOrder, g, S, E); }
        SEAM();
        { pg8::Gemm g{hb, (const bf16_t*)(ws + (l ? WS_WUP1 : WS_WUP0)), NTOK, 2 * DFF, 1024, 1024, 1024}; pg8::StaticOrder S; S.init(NTOK, 2 * DFF, G, bx);
          EpiUpConv E{ss + (l ? 3 : 1) * NTOK, abuf, a.in[22] + l * 3 * DFF, a.in[23] + l * DFF, ghead, gtail};
          pg8::gemm_phase<EpiUpConv, pg8::StaticOrder, true, true, 1>(ldsl, g, S, E); }
        SEAM();
        { pg8::Gemm g{abuf, (const bf16_t*)(ws + (l ? WS_WDN1 : WS_WDN0)), NTOK, 1024, DFF, DFF, DFF}; pg8::StaticOrder S; S.init(NTOK, 1024, G, bx);
          { TIDS(); pg8::Unit uu; for (int i = 0; S.next(i, uu); ++i) convfix_panel(abuf, ghead, gtail, a.in[22] + l * 3 * DFF, uu.pm, tid); }
          asm volatile("s_waitcnt vmcnt(0)" ::: "memory"); __syncthreads();
          EpiResFfn E{(const void*)hb, out, (bf16_t*)nullptr, ss + 4 * NTOK}; GEMM_CALL(EpiResFfn, pg8::StaticOrder, g, S, E); }
        SEAM();
    }
    {
        TIDS();
        const float* ss4 = ss + 4 * NTOK; f32x4 gg[4];
#pragma unroll
        for (int j = 0; j < 4; ++j) gg[j] = ((const f32x4*)a.in[25])[64 * j + lane];
#pragma unroll 1
        for (int m0 = (bx * NWAVES + wid) * 4; m0 < NTOK; m0 += G * NWAVES * 4) {
            f32x4 v[4][4]; float rs[4];
#pragma unroll
            for (int r = 0; r < 4; ++r) { rs[r] = ss4[m0 + r];
#pragma unroll
                for (int j = 0; j < 4; ++j) v[r][j] = ((const f32x4*)(out + (size_t)(m0 + r) * 1024))[64 * j + lane]; }
#pragma unroll
            for (int r = 0; r < 4; ++r) { const float s = rstd_of(rs[r]);
#pragma unroll
                for (int j = 0; j < 4; ++j) ((f32x4*)(out + (size_t)(m0 + r) * 1024))[64 * j + lane] = v[r][j] * s * gg[j]; }
        }
    }
}

extern "C" void kernel_launch(void* const* d_in, const int* in_sizes, int n_in, void* d_out, int out_size, void* d_ws, size_t ws_size, hipStream_t stream) {
    static int grid = 0;
    if (grid == 0) {
        if (n_in != 26 || out_size != NTOK * DM || ws_size < WS_END) { fprintf(stderr, "kernel_launch: unexpected shapes (n_in %d out %d ws %zu)\n", n_in, out_size, ws_size); grid = -1; return; }
        int dev = 0, cus = 0, per_cu = 0;
        hipGetDevice(&dev); hipDeviceGetAttribute(&cus, hipDeviceAttributeMultiprocessorCount, dev);
        hipFuncSetAttribute((const void*)fwd_megakernel, hipFuncAttributeMaxDynamicSharedMemorySize, LDS_BYTES);
        hipOccupancyMaxActiveBlocksPerMultiprocessor(&per_cu, (const void*)fwd_megakernel, NTHREADS, LDS_BYTES);
        if (per_cu < 1) { fprintf(stderr, "kernel_launch: occupancy query reports %d blocks/CU\n", per_cu); per_cu = 1; }
        (void)hipGetLastError();
        grid = cus * per_cu;
    }
    if (grid < 0) return;
    Args a{};
    for (int i = 0; i < 26; ++i) a.in[i] = (const float*)d_in[i];
    a.out = (float*)d_out; a.ws = (unsigned char*)d_ws;
    void* args[] = {&a};
    hipError_t e = hipLaunchCooperativeKernel((const void*)fwd_megakernel, dim3(grid), dim3(NTHREADS), args, LDS_BYTES, stream);
    if (e != hipSuccess) fprintf(stderr, "cooperative launch failed: %s (grid %d)\n", hipGetErrorString(e), grid);
}
```

```cpp
#include <hip/hip_runtime.h>
#include <hip/hip_cooperative_groups.h>
#include <hip/hip_bf16.h>
#include <cstdio>
#include <cstdint>
#include <cmath>
namespace cg = cooperative_groups;
namespace pg8 {
#define PG8_LAS __attribute__((address_space(3)))
typedef unsigned short bf16_t;
typedef short bf16x8 __attribute__((ext_vector_type(8)));
typedef float f32x4 __attribute__((ext_vector_type(4)));
typedef unsigned u32x4 __attribute__((ext_vector_type(4)));
constexpr int BM = 256, BK = 64, HALF = 128, HTB = HALF * BK * 2  , STAGE_BYTES = 8 * HTB, NXCD = 8, WGM = 4;

__host__ __device__ __forceinline__ int lds_byte(int r, int c) { const int st = (r >> 4) * 2 + (c >> 5), rr = r & 15, cc = c & 31, ob = rr * 64 + cc * 2; return st * 1024 + (ob ^ (((ob >> 9) & 1) << 5)); }
__host__ __device__ __forceinline__ void stage_rc(int b, int& R, int& C) { const int st = b / 1024, sb = b % 1024, swz = sb ^ (((sb >> 9) & 1) << 5); R = (st >> 1) * 16 + swz / 64; C = (st & 1) * 32 + (swz % 64) / 2; }
__host__ __device__ __forceinline__ int perm32(int rho) { const int n = rho >> 4, i = rho & 15; return 8 * (i >> 2) + 4 * n + (i & 3); }

struct Unit { int pm, pn; };
struct Gemm { const bf16_t* A; const bf16_t* Bt; int M, N, K, lda, ldb; };

struct StaticOrder {
    int nM, nN, nwg, G, c;
    __host__ __device__ __forceinline__ void init(int M, int N, int G_, int c_) { nM = M / BM; nN = N / BM; nwg = nM * nN; G = G_; c = c_; }
    __host__ __device__ __forceinline__ bool next(int i, Unit& u) const {
        const long L = (long)i * G + c; if (L >= nwg) return false;
        int wgid = (int)L; { const int q = nwg / NXCD, r = nwg % NXCD, xcd = wgid % NXCD, off = wgid / NXCD; wgid = (xcd < r ? xcd * (q + 1) : r * (q + 1) + (xcd - r) * q) + off; }
        const int nig = WGM * nN, gid = wgid / nig, fm = gid * WGM, gsz = (nM - fm) < WGM ? (nM - fm) : WGM;
        u.pm = fm + ((wgid % nig) % gsz); u.pn = (wgid % nig) / gsz; return true;
    }
    __device__ __forceinline__ void a_ready(const Unit&) const {}
    __device__ __forceinline__ void done(const Unit&) const {}
};

__device__ __forceinline__ unsigned cvt_pk_bf16(float lo, float hi) { unsigned r; asm volatile("v_cvt_pk_bf16_f32 %0, %1, %2" : "=v"(r) : "v"(lo), "v"(hi)); return r; }
template <class Epi, class Sched, bool ALIGN_EPI = false, bool SP2 = false, int AMODE = 0>
__device__ __forceinline__ void gemm_phase(PG8_LAS unsigned char* lds, const Gemm g, const Sched& S, const Epi& E) {
    int tid_o = threadIdx.x; asm volatile("" : "+v"(tid_o)); const int tid = tid_o, wid = __builtin_amdgcn_readfirstlane(tid >> 6), lane = tid & 63, wr = wid >> 2, wc = wid & 3, fr = lane & 15, fq = lane >> 4;
    const int K = g.K, nt = K / BK;
    unsigned voffA[2], voffB[2];
#pragma unroll
    for (int i = 0; i < 2; ++i) { int R, C; stage_rc(tid * 16 + i * 8192, R, C); const int Rb = Epi::PERM ? ((R & ~31) + perm32(R & 31)) : R;
        const int Ra = (AMODE == 1) ? ((R >> 6) * 128 + (R & 15) * 8 + ((R >> 4) & 3)) : R;
        voffA[i] = (unsigned)(Ra * g.lda + C) * 2u; voffB[i] = (unsigned)(Rb * g.ldb + C) * 2u; }
    const size_t kstep = (size_t)(BK * 2);
    const size_t hstepA = (AMODE == 1) ? (size_t)4 * g.lda * 2 : (size_t)HALF * g.lda * 2, hstepB = (size_t)HALF * g.ldb * 2;
    const size_t tstepA = (size_t)BM * g.lda * 2, tstepB = (size_t)BM * g.ldb * 2;
    const unsigned ldsw = (unsigned)wid * 1024u;
    const int aoff = lds_byte(wr * 64 + fr, fq * 8), boff = lds_byte(wc * 32 + fr, fq * 8);
#define PG8_SA(b, h) (((b) * 2 + (h)) * HTB)
#define PG8_SB(b, h) ((4 + (b) * 2 + (h)) * HTB)
#define PG8_STAGE(bufoff, gbase, voff) do { _Pragma("unroll") for (int _i = 0; _i < 2; ++_i) \
        __builtin_amdgcn_global_load_lds((const unsigned*)((const char*)(gbase) + (voff)[_i]), (PG8_LAS unsigned*)(lds + (bufoff) + ldsw + _i * 8192), 16, 0, 0); } while (0)
#define PG8_LDA(dst, b, h) do { _Pragma("unroll") for (int m = 0; m < 4; ++m) _Pragma("unroll") for (int k = 0; k < 2; ++k) dst[m][k] = *(const PG8_LAS bf16x8*)(lds + PG8_SA(b, h) + aoff + m * 2048 + k * 1024); } while (0)
#define PG8_LDB(dst, b, h) do { _Pragma("unroll") for (int n = 0; n < 2; ++n) _Pragma("unroll") for (int k = 0; k < 2; ++k) dst[n][k] = *(const PG8_LAS bf16x8*)(lds + PG8_SB(b, h) + boff + n * 2048 + k * 1024); } while (0)
#define PG8_MMA(ai, bj, At, Bt) do { __builtin_amdgcn_s_setprio(1); _Pragma("unroll") for (int m = 0; m < 4; ++m) _Pragma("unroll") for (int n = 0; n < 2; ++n) _Pragma("unroll") for (int k = 0; k < 2; ++k) \
        acc[ai][bj][m][n] = __builtin_amdgcn_mfma_f32_16x16x32_bf16(Bt[n][k], At[m][k], acc[ai][bj][m][n], 0, 0, 0); __builtin_amdgcn_s_setprio(0); } while (0)
#define PG8_WAIT_V(n) asm volatile("s_waitcnt vmcnt(" #n ")" ::: "memory")
#define PG8_WAIT_L(n) asm volatile("s_waitcnt lgkmcnt(" #n ")" ::: "memory")
#define PG8_BAR __builtin_amdgcn_s_barrier()
#define PG8_SCHED __builtin_amdgcn_sched_barrier(0)
    Unit cur, nxt; int ui = 0;
    if (!S.next(0, cur)) return;
    f32x4 acc[2][2][4][2];
#pragma unroll
    for (int a = 0; a < 2; ++a)
#pragma unroll
        for (int b = 0; b < 2; ++b)
#pragma unroll
            for (int m = 0; m < 4; ++m)
#pragma unroll
                for (int n = 0; n < 2; ++n) acc[a][b][m][n] = (f32x4){0.f, 0.f, 0.f, 0.f};
    bf16x8 At[4][2], B0[2][2], B1[2][2];
    const char* cA = (const char*)g.A + (size_t)cur.pm * tstepA; const char* cB = (const char*)g.Bt + (size_t)cur.pn * tstepB;
    S.a_ready(cur);
    if constexpr (SP2) {
        PG8_STAGE(PG8_SB(0, 0), cB, voffB); PG8_STAGE(PG8_SB(0, 1), cB + hstepB, voffB); PG8_STAGE(PG8_SA(0, 0), cA, voffA); PG8_STAGE(PG8_SA(0, 1), cA + hstepA, voffA);
        if (wr == 1) PG8_BAR;
        PG8_WAIT_V(2); PG8_BAR;
        PG8_STAGE(PG8_SB(1, 0), cB + kstep, voffB); PG8_STAGE(PG8_SA(1, 0), cA + kstep, voffA); PG8_STAGE(PG8_SB(1, 1), cB + hstepB + kstep, voffB);
        PG8_WAIT_V(6); PG8_BAR;
    } else {
        PG8_STAGE(PG8_SB(0, 0), cB, voffB); PG8_STAGE(PG8_SA(0, 0), cA, voffA); PG8_STAGE(PG8_SB(0, 1), cB + hstepB, voffB); PG8_STAGE(PG8_SA(0, 1), cA + hstepA, voffA);
        if (wr == 1) PG8_BAR;
        PG8_WAIT_V(4); PG8_BAR;
        PG8_STAGE(PG8_SB(1, 0), cB + kstep, voffB); PG8_STAGE(PG8_SA(1, 0), cA + kstep, voffA); PG8_STAGE(PG8_SB(1, 1), cB + hstepB + kstep, voffB);
        PG8_WAIT_V(6); PG8_BAR;
    }
    for (;;) {
        const bool has_next = S.next(ui + 1, nxt);
        const char* nA = has_next ? (const char*)g.A + (size_t)nxt.pm * tstepA : cA; const char* nB = has_next ? (const char*)g.Bt + (size_t)nxt.pn * tstepB : cB;
        for (int t = 0; t < nt; t += 2) {
            const bool last = (t == nt - 2);
            const char* a1 = cA + (size_t)(t + 1) * kstep;
            const char* a2 = last ? nA : cA + (size_t)(t + 2) * kstep; const char* b2 = last ? nB : cB + (size_t)(t + 2) * kstep;
            const char* a3 = a2 + kstep; const char* b3 = b2 + kstep;
            if (last && has_next) S.a_ready(nxt);
            if constexpr (SP2) {
            PG8_LDB(B0, 0, 0); PG8_LDB(B1, 0, 1); PG8_SCHED; PG8_LDA(At, 0, 0); PG8_STAGE(PG8_SA(1, 1), a1 + hstepA, voffA);
            PG8_WAIT_V(8); PG8_WAIT_L(0); PG8_BAR; PG8_MMA(0, 0, At, B0); PG8_MMA(0, 1, At, B1); PG8_BAR; PG8_SCHED;
            PG8_LDA(At, 0, 1); PG8_STAGE(PG8_SB(0, 0), b2, voffB); PG8_STAGE(PG8_SB(0, 1), b2 + hstepB, voffB); PG8_STAGE(PG8_SA(0, 0), a2, voffA);
            PG8_WAIT_V(8); PG8_WAIT_L(0); PG8_BAR; PG8_MMA(1, 0, At, B0); PG8_MMA(1, 1, At, B1); PG8_BAR; PG8_SCHED;
            PG8_LDB(B0, 1, 0); PG8_LDB(B1, 1, 1); PG8_SCHED; PG8_LDA(At, 1, 0); PG8_STAGE(PG8_SA(0, 1), a2 + hstepA, voffA);
            PG8_WAIT_V(8); PG8_WAIT_L(0); PG8_BAR; PG8_MMA(0, 0, At, B0); PG8_MMA(0, 1, At, B1); PG8_BAR; PG8_SCHED;
            PG8_LDA(At, 1, 1); PG8_STAGE(PG8_SB(1, 0), b3, voffB); PG8_STAGE(PG8_SB(1, 1), b3 + hstepB, voffB); PG8_STAGE(PG8_SA(1, 0), a3, voffA);
            PG8_WAIT_V(8); PG8_WAIT_L(0); PG8_BAR; PG8_MMA(1, 0, At, B0); PG8_MMA(1, 1, At, B1); PG8_BAR; PG8_SCHED;
            } else {
            PG8_LDB(B0, 0, 0); PG8_SCHED; PG8_LDA(At, 0, 0); PG8_STAGE(PG8_SA(1, 1), a1 + hstepA, voffA);
            PG8_WAIT_L(8); PG8_BAR; PG8_WAIT_L(0); PG8_MMA(0, 0, At, B0); PG8_BAR; PG8_SCHED;
            PG8_LDB(B1, 0, 1); PG8_STAGE(PG8_SB(0, 0), b2, voffB);
            PG8_BAR; PG8_WAIT_L(0); PG8_MMA(0, 1, At, B1); PG8_BAR;
            PG8_LDA(At, 0, 1); PG8_STAGE(PG8_SA(0, 0), a2, voffA);
            PG8_BAR; PG8_WAIT_L(0); PG8_MMA(1, 0, At, B0); PG8_BAR; PG8_SCHED;
            PG8_STAGE(PG8_SB(0, 1), b2 + hstepB, voffB);
            PG8_WAIT_V(6); PG8_BAR; PG8_MMA(1, 1, At, B1); PG8_BAR;
            PG8_LDB(B0, 1, 0); PG8_SCHED; PG8_LDA(At, 1, 0); PG8_STAGE(PG8_SA(0, 1), a2 + hstepA, voffA);
            PG8_WAIT_L(8); PG8_BAR; PG8_WAIT_L(0); PG8_MMA(0, 0, At, B0); PG8_BAR; PG8_SCHED;
            PG8_LDB(B1, 1, 1); PG8_STAGE(PG8_SB(1, 0), b3, voffB);
            PG8_BAR; PG8_WAIT_L(0); PG8_MMA(0, 1, At, B1); PG8_BAR;
            PG8_LDA(At, 1, 1); PG8_STAGE(PG8_SA(1, 0), a3, voffA);
            PG8_BAR; PG8_WAIT_L(0); PG8_MMA(1, 0, At, B0); PG8_BAR; PG8_SCHED;
            PG8_STAGE(PG8_SB(1, 1), b3 + hstepB, voffB);
            PG8_WAIT_V(6); PG8_BAR; PG8_MMA(1, 1, At, B1); PG8_BAR;
            }
        }
        if constexpr (ALIGN_EPI) { if (wr == 0) PG8_BAR; }
        if constexpr (!Epi::AFTER_DRAIN) { E(acc, cur, wr, wc, fr, fq); S.done(cur); }
        if (!has_next) break;
#pragma unroll
        for (int a = 0; a < 2; ++a)
#pragma unroll
            for (int b = 0; b < 2; ++b)
#pragma unroll
                for (int m = 0; m < 4; ++m)
#pragma unroll
                    for (int n = 0; n < 2; ++n) acc[a][b][m][n] = (f32x4){0.f, 0.f, 0.f, 0.f};
        cur = nxt; cA = nA; cB = nB; ++ui;
        if constexpr (ALIGN_EPI) { if (wr == 1) PG8_BAR; }
    }
    PG8_WAIT_V(0);
    if constexpr (!ALIGN_EPI) { if (wr == 0) PG8_BAR; }
    PG8_BAR;
    if constexpr (Epi::AFTER_DRAIN) { E.fused(acc, cur, wr, wc, fr, fq, lds, wid, lane); S.done(cur); }
#undef PG8_SA
#undef PG8_SB
#undef PG8_STAGE
#undef PG8_LDA
#undef PG8_LDB
#undef PG8_MMA
#undef PG8_WAIT_V
#undef PG8_WAIT_L
#undef PG8_BAR
#undef PG8_SCHED
}
}
#include <hip/hip_bf16.h>
namespace attn_body {
using bf16=__hip_bfloat16;
using bf16x8=__attribute__((ext_vector_type(8)))short;
using s16x4=__attribute__((ext_vector_type(4)))short;
using f32x16=__attribute__((ext_vector_type(16)))float;
using u32x4=__attribute__((ext_vector_type(4)))unsigned;
constexpr int D=64;
constexpr int NW=8,QBLK=32,QB=QBLK*NW,KVBLK=64;
constexpr int ATTN_UNIT_ROWS=QB; typedef float f32x4_t __attribute__((ext_vector_type(4))); typedef const __attribute__((address_space(3))) f32x4_t* lds_f4p;
__device__ __forceinline__ int crow(int r,int hi){return (r&3)+8*(r>>2)+4*hi;}
#define SBAR() __builtin_amdgcn_sched_barrier(0)
__device__ __forceinline__ void cmask(f32x16&p0,f32x16&p1,int jb,int qrel,int hi){
  const float NEG=-INFINITY; int kb=64*jb+4*hi;
  #pragma unroll
  for(int r=0;r<16;++r){int kv=kb+(r&3)+8*(r>>2); if(kv>qrel)p0[r]=NEG; if(kv+32>qrel)p1[r]=NEG;}
}

constexpr int NSLOT=3, SLOTB=8192;
constexpr int LDS_K=0, LDS_V=NSLOT*SLOTB, LDS_WS=2*NSLOT*SLOTB, LDS_OST=LDS_WS+NW*64*4, LDS_BYTES=LDS_OST+NW*4096;
constexpr float C2=0.125f*1.4426950408889634f;
__device__ __forceinline__ void glds16(const void*gsrc,unsigned lds_dst){unsigned keep;
  asm volatile("s_mov_b32 %0, m0\n\ts_mov_b32 m0, %2\n\ts_nop 0\n\tglobal_load_lds_dwordx4 %1, off\n\ts_mov_b32 m0, %0":"=&s"(keep):"v"(gsrc),"s"(lds_dst):"memory");}
__device__ __forceinline__ float max3f(float a,float b,float c){float r;asm("v_max3_f32 %0, %1, %2, %3":"=v"(r):"v"(a),"v"(b),"v"(c));return r;}
__device__ __forceinline__ float max2f(float a,float b){float r;asm("v_max_f32_e32 %0, %1, %2":"=v"(r):"v"(a),"v"(b));return r;}
__device__ __forceinline__ float fadd_s(float a,float b){float r;asm("v_add_f32_e32 %0, %1, %2":"=v"(r):"v"(a),"v"(b));return r;}
__device__ __forceinline__ float fsub_s(float a,float b){float r;asm("v_sub_f32_e32 %0, %1, %2":"=v"(r):"v"(a),"v"(b));return r;}
typedef float f32x2_t __attribute__((ext_vector_type(2))); typedef __bf16 bf16x2_t __attribute__((ext_vector_type(2)));
__device__ __forceinline__ unsigned cvtpk_s(float lo,float hi){f32x2_t v={lo,hi};bf16x2_t b=__builtin_convertvector(v,bf16x2_t);return __builtin_bit_cast(unsigned,b);}
#define WAIT_BAR(N) asm volatile("s_waitcnt vmcnt(" #N ") lgkmcnt(0)\n\ts_barrier":::"memory")

__device__ __forceinline__ void qkt(f32x16&p0,f32x16&p1,const char*Kslot,const bf16x8*qr,const f32x16&c0,const f32x16&c1,int r32,int hi){
  const char*kb=Kslot+hi*1024+r32*16;
  #pragma unroll
  for(int d0=0;d0<4;++d0){
    const bf16x8 b0=*reinterpret_cast<const bf16x8*>(kb+d0*2048);
    const bf16x8 b1=*reinterpret_cast<const bf16x8*>(kb+d0*2048+512);
    if(d0==0){p0=__builtin_amdgcn_mfma_f32_32x32x16_bf16(b0,qr[0],c0,0,0,0);p1=__builtin_amdgcn_mfma_f32_32x32x16_bf16(b1,qr[0],c1,0,0,0);}
    else{p0=__builtin_amdgcn_mfma_f32_32x32x16_bf16(b0,qr[d0],p0,0,0,0);p1=__builtin_amdgcn_mfma_f32_32x32x16_bf16(b1,qr[d0],p1,0,0,0);}}
}
typedef __attribute__((address_space(3))) const char* lds_cptr;
typedef short v4i16_t __attribute__((ext_vector_type(4)));
__device__ __forceinline__ void kload8(bf16x8*kf,lds_cptr kp){
  kf[0]=*(const __attribute__((address_space(3))) bf16x8*)(kp);      kf[1]=*(const __attribute__((address_space(3))) bf16x8*)(kp+512);
  kf[2]=*(const __attribute__((address_space(3))) bf16x8*)(kp+2048); kf[3]=*(const __attribute__((address_space(3))) bf16x8*)(kp+2560);
  kf[4]=*(const __attribute__((address_space(3))) bf16x8*)(kp+4096); kf[5]=*(const __attribute__((address_space(3))) bf16x8*)(kp+4608);
  kf[6]=*(const __attribute__((address_space(3))) bf16x8*)(kp+6144); kf[7]=*(const __attribute__((address_space(3))) bf16x8*)(kp+6656);
}
__device__ __forceinline__ void kload2(bf16x8*kf,lds_cptr kp,int j){ kf[2*j]=*(const __attribute__((address_space(3))) bf16x8*)(kp+j*2048); kf[2*j+1]=*(const __attribute__((address_space(3))) bf16x8*)(kp+j*2048+512); }
__device__ __forceinline__ s16x4 vtr(lds_cptr p){ return __builtin_bit_cast(s16x4,__builtin_amdgcn_ds_read_tr16_b64_v4i16((__attribute__((address_space(3))) v4i16_t*)p)); }
__device__ __forceinline__ float rowmax(const f32x16&p0,const f32x16&p1){
  float a=max3f(p0[0],p0[1],p1[0]),b=max3f(p0[2],p0[3],p1[1]);a=max3f(a,p1[2],p1[3]);
  #pragma unroll
  for(int r=4;r<16;r+=4){a=max3f(a,p0[r],p0[r+1]);b=max3f(b,p0[r+2],p0[r+3]);a=max3f(a,p1[r],p1[r+1]);b=max3f(b,p1[r+2],p1[r+3]);}
  const float m=max2f(a,b);
  auto rr=__builtin_amdgcn_permlane32_swap(__float_as_uint(m),__float_as_uint(m),false,false);
  return max2f(__uint_as_float(rr[0]),__uint_as_float(rr[1]));
}
__device__ __forceinline__ void pv(f32x16*o,int vb,bf16x8 pa0,bf16x8 pa1,bf16x8 pa2,bf16x8 pa3){
  #pragma unroll
  for(int d0=0;d0<2;++d0){s16x4 lo[4],hi[4];
    #pragma unroll
    for(int ks=0;ks<4;++ks){
      asm volatile("ds_read_b64_tr_b16 %0,%1 offset:%c2":"=&v"(lo[ks]):"v"(vb),"i"(d0*4096+ks*1024):"memory");
      asm volatile("ds_read_b64_tr_b16 %0,%1 offset:%c2":"=&v"(hi[ks]):"v"(vb),"i"(d0*4096+ks*1024+512):"memory");}
    asm volatile("s_waitcnt lgkmcnt(0)":::"memory");SBAR();
    #define PK(k) (bf16x8){lo[k][0],lo[k][1],lo[k][2],lo[k][3],hi[k][0],hi[k][1],hi[k][2],hi[k][3]}
    o[d0]=__builtin_amdgcn_mfma_f32_32x32x16_bf16(pa0,PK(0),o[d0],0,0,0);
    o[d0]=__builtin_amdgcn_mfma_f32_32x32x16_bf16(pa1,PK(1),o[d0],0,0,0);
    o[d0]=__builtin_amdgcn_mfma_f32_32x32x16_bf16(pa2,PK(2),o[d0],0,0,0);
    o[d0]=__builtin_amdgcn_mfma_f32_32x32x16_bf16(pa3,PK(3),o[d0],0,0,0);
    #undef PK
  }
}

#ifndef ATTN_STORE16
#define ATTN_STORE16(p,v) (*(u32x4*)(p)=(v))
#endif
template<int THRL,bool CAUSAL,bool BIAS,int PQ,int PKV,bool REV=false,bool SKIP=false> __device__ __forceinline__ void attn_unit(const bf16*Q0,const bf16*__restrict__ Kh,const bf16*__restrict__ Vh,bf16*O0,const int NTI,lds_f4p btab,char*shm,float kmaxv=0.f,__attribute__((address_space(3))) float*xq=nullptr){
  int NT=NTI;
  int tid_o=threadIdx.x; asm volatile("":"+v"(tid_o)); const int tid=tid_o,lane=tid&63,r32=lane&31,hi=lane>>5; const int wid=__builtin_amdgcn_readfirstlane(tid>>6);
  const bf16*Qw=Q0+(long)(wid*QBLK)*PQ;
  const unsigned lds0=(unsigned)(uintptr_t)shm;
  float*wsf=(float*)(shm+LDS_WS)+wid*64;
  const bf16*ksrc=Kh+(long)lane*PKV+wid*8;
  const bf16*vsrc=Vh+(long)(16*(wid&3)+(lane>>2))*PKV+(wid>>2)*32+(lane&3)*8;
  const unsigned kdst=lds0+LDS_K+wid*1024, vdst=lds0+LDS_V+wid*1024;
  #define TIX(t) (REV?(NTI-1-(t)):(t))
  #define DMA_K(t,slot) glds16(ksrc+(long)TIX(t)*KVBLK*PKV,(unsigned)__builtin_amdgcn_readfirstlane(kdst+(slot)))
  #define DMA_V(t,slot) glds16(vsrc+(long)TIX(t)*KVBLK*PKV,(unsigned)__builtin_amdgcn_readfirstlane(vdst+(slot)))
  const int vb0=(int)(lds0+LDS_V)+((lane>>4)&1)*32+(lane&3)*8+(4*hi+((lane&15)>>2))*64;
  const char*Kbase=shm+LDS_K; bf16x8 kf[8];
  const lds_cptr shm3=(lds_cptr)shm; const lds_cptr kp0=shm3+LDS_K+hi*1024+r32*16; const lds_cptr vp0=shm3+LDS_V+((lane>>4)&1)*32+(lane&3)*8+(4*hi+((lane&15)>>2))*64;
  DMA_K(0,0);DMA_V(0,0);DMA_K(1,SLOTB);
  bf16x8 qr[4];
  #pragma unroll
  for(int d0=0;d0<4;++d0)qr[d0]=*reinterpret_cast<const bf16x8*>(&Qw[(long)r32*PQ+d0*16+hi*8]);
  if(SKIP){ float qsq=0.f;
    _Pragma("unroll") for(int d0=0;d0<4;++d0) _Pragma("unroll") for(int e=0;e<8;++e){ const float f=__uint_as_float(((unsigned)(unsigned short)qr[d0][e])<<16); qsq+=f*f; }
    { auto rr=__builtin_amdgcn_permlane32_swap(__float_as_uint(qsq),__float_as_uint(qsq),false,false); qsq=__uint_as_float(rr[0])+__uint_as_float(rr[1]); }
    _Pragma("unroll") for(int o_=1;o_<32;o_<<=1) qsq=__builtin_fmaxf(qsq,__shfl_xor(qsq,o_));
    if(lane==0) xq[wid]=qsq; }
  float mhat=0.f,l_reg=0.f;f32x16 o[2];o[0]=f32x16{};o[1]=f32x16{};f32x16 negm=f32x16{}; if(!BIAS){asm volatile("":"+v"(negm));}
  const int qrel=wid*QBLK+r32;
  #define CMASK(P0,P1,t) do{ if(CAUSAL){int jb_=REV?3-(t):(t)-(NT-4); if(jb_>=0)cmask(P0,P1,jb_,qrel,hi);} }while(0)
  bool resc=false;
  #define START(P0,P1) do{ const float rm=rowmax(P0,P1); resc=false; \
    { const float dl=(rm==-INFINITY)?0.f:rm; mhat=fadd_s(mhat,dl); \
      _Pragma("unroll") for(int r=0;r<16;++r){P0[r]=fsub_s(P0[r],dl);P1[r]=fsub_s(P1[r],dl);} \
      if(!BIAS){ _Pragma("unroll") for(int r=0;r<16;++r)negm[r]=-mhat; asm volatile("":"+v"(negm)); } } \
    _Pragma("unroll") for(int r=0;r<16;++r)P0[r]=__builtin_amdgcn_exp2f(P0[r]); }while(0)
  #define RESC() do{ if(resc){ asm volatile("s_waitcnt lgkmcnt(0)":::"memory"); \
      _Pragma("unroll") for(int d_=0;d_<2;++d_) _Pragma("unroll") for(int r=0;r<16;++r)o[d_][r]*=wsf[crow(r,hi)]; } }while(0)
  #define BFILL(C0,C1,t) do{ if(BIAS){ const lds_f4p bt_=btab+TIX(t)*16+hi; \
    _Pragma("unroll") for(int j_=0;j_<4;++j_){ const f32x4_t v0_=bt_[2*j_], v1_=bt_[2*j_+8]; \
      C0[4*j_]=v0_[0]-mhat; C0[4*j_+1]=v0_[1]-mhat; C0[4*j_+2]=v0_[2]-mhat; C0[4*j_+3]=v0_[3]-mhat; \
      C1[4*j_]=v1_[0]-mhat; C1[4*j_+1]=v1_[1]-mhat; C1[4*j_+2]=v1_[2]-mhat; C1[4*j_+3]=v1_[3]-mhat; } } }while(0)
  f32x16 pA0,pA1,pB0,pB1;
  int sl_prev=0,sl_cur=0,sl_next=SLOTB;
  #define ROT() do{sl_prev=sl_cur;sl_cur=sl_next;sl_next=(sl_next==(NSLOT-1)*SLOTB)?0:sl_next+SLOTB;}while(0)
  DMA_K(2,2*SLOTB);
  WAIT_BAR(3);
  if(SKIP){
    float q2=xq[0]; _Pragma("unroll") for(int w_=1;w_<8;++w_) q2=__builtin_fmaxf(q2,xq[w_]);
    const float qk2=2.f*__builtin_sqrtf(q2)*kmaxv; const __attribute__((address_space(3))) float*bf_=(const __attribute__((address_space(3))) float*)btab; const float bq0=bf_[64*(NTI-4)];
    for(int c_=4;c_<NTI;c_+=2){ if(bf_[64*(NTI-c_)-1]-bq0+qk2<-170.f){ NT=c_; break; } } }
  BFILL(pA0,pA1,0); qkt(pA0,pA1,Kbase,qr,BIAS?pA0:negm,BIAS?pA1:negm,r32,hi);asm volatile("s_nop 15\n\ts_nop 7":"+v"(pA0),"+v"(pA1));CMASK(pA0,pA1,0);
  START(pA0,pA1);
  BFILL(pB0,pB1,1);
  _Pragma("unroll") for(int r=0;r<16;++r)pA1[r]=__builtin_amdgcn_exp2f(pA1[r]);
  WAIT_BAR(0);
  DMA_K(3,0);DMA_V(1,SLOTB);
  ROT();
  kload8(kf,kp0+sl_cur);
  WAIT_BAR(2);
  s16x4 vlo[8],vhi[8]; u32x4 pw0,pw1,pw2,pw3;
  #define PKW(P,B) cvtpk_s(P[B],P[B+1])
  #define PAF(k) __builtin_bit_cast(bf16x8,pw##k)
  #define VFR(i) (bf16x8){vlo[i][0],vlo[i][1],vlo[i][2],vlo[i][3],vhi[i][0],vhi[i][1],vhi[i][2],vhi[i][3]}
  #define PIN(x) asm volatile("":"+v"(x))
  #define MX3(a,b,c) __builtin_fmaxf(__builtin_fmaxf((a),(b)),(c))
  #define GAPA(MF,A0,A1,A2,A3,W0,W1,PW) do{ MF; sacc+=A0; sacc+=A1; sacc+=A2; sacc+=A3; PIN(sacc); W0; W1; PIN(PW); SBAR(); }while(0)
  #define EX(v) __builtin_amdgcn_exp2f(v)
  #define GAPB(MF,X,B,FL,PN,JJ,OFFN) do{ MF; X[B]=EX(X[B]); X[B+1]=EX(X[B+1]); X[B+2]=EX(X[B+2]); X[B+3]=EX(X[B+3]); \
    if(BIAS&&(FL)){ { f32x2_t a_={bq_[0],bq_[1]}, b_={bq_[2],bq_[3]}; const f32x2_t m2_={mhat,mhat}; a_-=m2_; b_-=m2_; PN[4*(JJ)]=a_[0]; PN[4*(JJ)+1]=a_[1]; PN[4*(JJ)+2]=b_[0]; PN[4*(JJ)+3]=b_[1]; } if((OFFN)>=0) bq_=btn_[(OFFN)>=0?(OFFN):0]; PIN(PN); } PIN(X); SBAR(); }while(0)
  #define VRD(i) do{ vlo[i]=vtr(vp_+(((i)>>2)*4096+((i)&3)*1024)); vhi[i]=vtr(vp_+(((i)>>2)*4096+((i)&3)*1024+512)); }while(0)
  #define KRD(G,j) do{ if(G){ kload2(kf,kp0+sl_next,j); SBAR(); } }while(0)
  #define STEP(C0,C1,P0,P1,t,GK,GV,GL) do{ SBAR(); \
    const lds_cptr vp_=vp0+sl_prev; \
    VRD(0); SBAR(); float sacc=(P0[0]+P0[1]); \
    GAPA(C0=__builtin_amdgcn_mfma_f32_32x32x16_bf16(kf[0],qr[0],BIAS?C0:negm,0,0,0), P0[2],P0[3],P0[4],P0[5],     pw0[0]=PKW(P0,0), pw0[1]=PKW(P0,2), pw0); \
    VRD(4); SBAR(); GAPA(C1=__builtin_amdgcn_mfma_f32_32x32x16_bf16(kf[1],qr[0],BIAS?C1:negm,0,0,0), P0[6],P0[7],P0[8],P0[9],     pw0[2]=PKW(P0,4), pw0[3]=PKW(P0,6), pw0); \
    VRD(1); SBAR(); GAPA(C0=__builtin_amdgcn_mfma_f32_32x32x16_bf16(kf[2],qr[1],C0,0,0,0),   P0[10],P0[11],P0[12],P0[13], pw1[0]=PKW(P0,8), pw1[1]=PKW(P0,10), pw1); \
    VRD(5); SBAR(); GAPA(C1=__builtin_amdgcn_mfma_f32_32x32x16_bf16(kf[3],qr[1],C1,0,0,0),   P0[14],P0[15],P1[0],P1[1],   pw1[2]=PKW(P0,12),pw1[3]=PKW(P0,14), pw1); \
    VRD(2); SBAR(); GAPA(C0=__builtin_amdgcn_mfma_f32_32x32x16_bf16(kf[4],qr[2],C0,0,0,0),   P1[2],P1[3],P1[4],P1[5],     pw2[0]=PKW(P1,0), pw2[1]=PKW(P1,2), pw2); \
    VRD(6); SBAR(); GAPA(C1=__builtin_amdgcn_mfma_f32_32x32x16_bf16(kf[5],qr[2],C1,0,0,0),   P1[6],P1[7],P1[8],P1[9],     pw2[2]=PKW(P1,4), pw2[3]=PKW(P1,6), pw2); \
    VRD(3); SBAR(); GAPA(C0=__builtin_amdgcn_mfma_f32_32x32x16_bf16(kf[6],qr[3],C0,0,0,0),   P1[10],P1[11],P1[12],P1[13], pw3[0]=PKW(P1,8), pw3[1]=PKW(P1,10), pw3); \
    VRD(7); SBAR(); GAPA(C1=__builtin_amdgcn_mfma_f32_32x32x16_bf16(kf[7],qr[3],C1,0,0,0),   P1[14],P1[15],0.f,0.f,       pw3[2]=PKW(P1,12),pw3[3]=PKW(P1,14), pw3); \
    l_reg+=sacc; \
    if(GK){DMA_K((t)+3,sl_cur);} if(GV){DMA_V((t)+1,sl_next);} \
    CMASK(C0,C1,t); \
    { float a=MX3(C0[0],C0[1],C1[0]),b=MX3(C0[2],C0[3],C1[1]); a=MX3(a,C1[2],C1[3]); \
      _Pragma("unroll") for(int r=4;r<16;r+=4){a=MX3(a,C0[r],C0[r+1]);b=MX3(b,C0[r+2],C0[r+3]);a=MX3(a,C1[r],C1[r+1]);b=MX3(b,C1[r+2],C1[r+3]);} \
      float rm=__builtin_fmaxf(a,b); { auto rr=__builtin_amdgcn_permlane32_swap(__float_as_uint(rm),__float_as_uint(rm),false,false); rm=__builtin_fmaxf(__uint_as_float(rr[0]),__uint_as_float(rr[1])); } \
      resc=false; \
      if(__builtin_expect(__any(rm>(float)THRL),0)){ const float dl=__builtin_fmaxf(rm,0.f); mhat+=dl; \
        _Pragma("unroll") for(int r=0;r<16;++r){C0[r]-=dl;C1[r]-=dl;} \
        if(!BIAS){ _Pragma("unroll") for(int r=0;r<16;++r)negm[r]=-mhat; asm volatile("":"+v"(negm)); } \
        const float f=__builtin_amdgcn_exp2f(-dl); l_reg*=f; if(hi==0)wsf[r32]=f; resc=true; } } \
    const lds_f4p btn_=btab+TIX((t)+1)*16+hi; f32x4_t bq_; if(BIAS&&(GL)) bq_=btn_[0]; \
    SBAR(); \
    GAPB(o[0]=__builtin_amdgcn_mfma_f32_32x32x16_bf16(PAF(0),VFR(0),o[0],0,0,0), C0,0, GL,P0,0,2); \
    GAPB(o[1]=__builtin_amdgcn_mfma_f32_32x32x16_bf16(PAF(0),VFR(4),o[1],0,0,0), C0,4, GL,P0,1,4); \
    KRD(GL,0); GAPB(o[0]=__builtin_amdgcn_mfma_f32_32x32x16_bf16(PAF(1),VFR(1),o[0],0,0,0), C0,8, GL,P0,2,6); \
    KRD(GL,1); GAPB(o[1]=__builtin_amdgcn_mfma_f32_32x32x16_bf16(PAF(1),VFR(5),o[1],0,0,0), C0,12, GL,P0,3,8); \
    KRD(GL,2); GAPB(o[0]=__builtin_amdgcn_mfma_f32_32x32x16_bf16(PAF(2),VFR(2),o[0],0,0,0), C1,0, GL,P1,0,10); \
    KRD(GL,3); GAPB(o[1]=__builtin_amdgcn_mfma_f32_32x32x16_bf16(PAF(2),VFR(6),o[1],0,0,0), C1,4, GL,P1,1,12); \
    GAPB(o[0]=__builtin_amdgcn_mfma_f32_32x32x16_bf16(PAF(3),VFR(3),o[0],0,0,0), C1,8, GL,P1,2,14); \
    GAPB(o[1]=__builtin_amdgcn_mfma_f32_32x32x16_bf16(PAF(3),VFR(7),o[1],0,0,0), C1,12, GL,P1,3,-1); \
    }while(0)
  int t=1;
  #undef CMASK
  #define CMASK(P0,P1,t) do{ if(REV&&CAUSAL){int jb_=3-(t); if(jb_>=0)cmask(P0,P1,jb_,qrel,hi);} }while(0)
  for(;t+5<NT;t+=2){
    STEP(pB0,pB1,pA0,pA1,t,true,true,true);     WAIT_BAR(2); RESC(); ROT();
    STEP(pA0,pA1,pB0,pB1,t+1,true,true,true);   WAIT_BAR(2); RESC(); ROT();
  }
  #undef CMASK
  #define CMASK(P0,P1,t) do{ if(CAUSAL){int jb_=REV?3-(t):(t)-(NT-4); if(jb_>=0)cmask(P0,P1,jb_,qrel,hi);} }while(0)
  #define ENDW(tt) do{ if((tt)+3<NT){WAIT_BAR(2);} else if((tt)+2<NT){WAIT_BAR(1);} else {WAIT_BAR(0);} }while(0)
  for(;t+1<NT;t+=2){
    STEP(pB0,pB1,pA0,pA1,t,(t+3<NT),(t+1<NT),(t+1<NT));       ENDW(t);   RESC(); ROT();
    STEP(pA0,pA1,pB0,pB1,t+1,(t+4<NT),(t+2<NT),(t+2<NT));     ENDW(t+1); RESC(); ROT();
  }
  STEP(pB0,pB1,pA0,pA1,NT-1,false,false,false); RESC();
  { float sacc=pB0[0]+pB0[1]; _Pragma("unroll") for(int r=2;r<16;++r)sacc+=pB0[r]; _Pragma("unroll") for(int r=0;r<16;++r)sacc+=pB1[r]; l_reg+=sacc;
    pw0=(u32x4){PKW(pB0,0),PKW(pB0,2),PKW(pB0,4),PKW(pB0,6)};pw1=(u32x4){PKW(pB0,8),PKW(pB0,10),PKW(pB0,12),PKW(pB0,14)};pw2=(u32x4){PKW(pB1,0),PKW(pB1,2),PKW(pB1,4),PKW(pB1,6)};pw3=(u32x4){PKW(pB1,8),PKW(pB1,10),PKW(pB1,12),PKW(pB1,14)};
    SBAR(); pv(o,vb0+sl_cur,PAF(0),PAF(1),PAF(2),PAF(3)); }
  #undef PKW
  #undef PAF
  #undef VFR
  #undef PIN
  #undef MX3
  #undef GAPA
  #undef GAPB
  #undef EX
  #undef VRD
  #undef KRD
  #undef STEP
  #undef ENDW
  {auto rr=__builtin_amdgcn_permlane32_swap(__float_as_uint(l_reg),__float_as_uint(l_reg),false,false);l_reg=__uint_as_float(rr[0])+__uint_as_float(rr[1]);}
  if(hi==0)wsf[32+r32]=l_reg;asm volatile("s_waitcnt lgkmcnt(0)":::"memory");
  float rli[16];
  #pragma unroll
  for(int r=0;r<16;++r)rli[r]=__builtin_amdgcn_rcpf(wsf[32+crow(r,hi)]);
  bf16*Ow=O0+(long)(wid*QBLK)*PQ;
  { bf16*stg=(bf16*)(shm+LDS_OST)+wid*2048;
    #pragma unroll
    for(int r=0;r<16;++r){const int orow=crow(r,hi);
      #pragma unroll
      for(int d0=0;d0<2;++d0)stg[orow*64+d0*32+r32]=__float2bfloat16(o[d0][r]*rli[r]);}
    asm volatile("s_waitcnt lgkmcnt(0)":::"memory");
    #pragma unroll
    for(int i=0;i<4;++i){const int row=i*8+(lane>>3),ch=lane&7; const u32x4 v=*(const u32x4*)(stg+row*64+ch*8); ATTN_STORE16(Ow+(long)row*PQ+ch*8,v);} }
  asm volatile("s_waitcnt lgkmcnt(0)\n\ts_barrier":::"memory");
  #undef DMA_K
  #undef DMA_V
  #undef CMASK
  #undef START
  #undef RESC
  #undef ROT
  #undef TIX
  #undef BFILL
}

#undef SBAR
#undef WAIT_BAR
}

#define LAS __attribute__((address_space(3)))
typedef unsigned short bf16_t;
typedef pg8::f32x4 f32x4;
typedef pg8::u32x4 u32x4;
typedef attn_body::bf16 abf16;

constexpr int NB = 8, SEQ = 4096, DM = 1024, NTOK = NB * SEQ, DTOK = 768, NGRP = 48, DFF = 2816, MEMT = 256, NHEAD = 12;
constexpr float EPS = 1e-6f, LOG2E = 1.4426950408889634f, C2 = 0.125f * 1.4426950408889634f, INV2PI = 0.15915494309189535f;
constexpr int NTHREADS = 512, NWAVES = 8;
constexpr int LDS_BYTES = 147456;
constexpr int LDS_BTAB = 98304, LDS_WSUM = 114688;

constexpr size_t MiB = (size_t)1 << 20;
constexpr size_t WS_SS = 0;
constexpr size_t WS_LOGF = 1 * MiB;
constexpr size_t WS_KMAX = 3 * MiB + 65536;
constexpr size_t WS_BAR = 3 * MiB;
constexpr size_t WS_WIN0 = 4 * MiB, WS_WOUT0 = 6 * MiB, WS_WOUT1 = 8 * MiB, WS_WUP0 = 10 * MiB, WS_WUP1 = 21 * MiB;
constexpr size_t WS_WDN0 = 32 * MiB, WS_WDN1 = 38 * MiB, WS_WGLU = 44 * MiB, WS_WKVQ = 46 * MiB, WS_WMKV0 = 51 * MiB, WS_WMKV1 = 52 * MiB;
constexpr size_t WS_BT1 = 53 * MiB, WS_BT3 = 59 * MiB, WS_MEMN = 68 * MiB, WS_MEMKV0 = 72 * MiB, WS_MEMKV1 = 74 * MiB;
constexpr size_t WS_HB = 76 * MiB;
constexpr size_t WS_R = 140 * MiB;
constexpr size_t WS_PROJ0 = WS_R, WS_A3 = WS_R + 64 * MiB, WS_SLOC = WS_R + 136 * MiB, WS_GB = WS_R + 184 * MiB, WS_TOKMIX = WS_R + 232 * MiB;
constexpr size_t WS_ABUF = WS_R, WS_GBUF = WS_R + 176 * MiB;
constexpr size_t WS_KV = WS_R, WS_PROJ1 = WS_R + 96 * MiB;
constexpr size_t WS_END = WS_R + 352 * MiB;

__device__ __forceinline__ unsigned pk2(float lo, float hi) { return pg8::cvt_pk_bf16(lo, hi); }
__device__ __forceinline__ float bf_lo(unsigned w) { return __uint_as_float(w << 16); }
__device__ __forceinline__ float bf_hi(unsigned w) { return __uint_as_float(w & 0xffff0000u); }
__device__ __forceinline__ bf16_t f2bf(float f) { return (bf16_t)(pk2(f, 0.f) & 0xffffu); }
__device__ __forceinline__ float wave_sum(float v) {
#pragma unroll
    for (int o = 1; o < 64; o <<= 1) v += __shfl_xor(v, o);
    return v;
}
__device__ __forceinline__ float fexp(float x) { return __builtin_amdgcn_exp2f(x * LOG2E); }
__device__ __forceinline__ float frcp(float x) { return __builtin_amdgcn_rcpf(x); }
__device__ __forceinline__ float sigm(float x) { return frcp(1.f + fexp(-x)); }
__device__ __forceinline__ float gelu_tanh(float x) {
    const float z = 0.7978845608028654f * (x + 0.044715f * x * x * x);
    const float e = fexp(2.f * z);
    const float th = 1.f - 2.f * frcp(1.f + e);
    return 0.5f * x * (1.f + th);
}
__device__ __forceinline__ float rstd_of(float ss) { return __builtin_amdgcn_rsqf(ss * (1.f / 1024.f) + EPS); }
__device__ __forceinline__ void unpack8(const u32x4 w, float (&f)[8]) {
    f[0] = bf_lo(w.x); f[1] = bf_hi(w.x); f[2] = bf_lo(w.y); f[3] = bf_hi(w.y); f[4] = bf_lo(w.z); f[5] = bf_hi(w.z); f[6] = bf_lo(w.w); f[7] = bf_hi(w.w);
}
__device__ __forceinline__ u32x4 pack8(const float (&f)[8]) { u32x4 w; w.x = pk2(f[0], f[1]); w.y = pk2(f[2], f[3]); w.z = pk2(f[4], f[5]); w.w = pk2(f[6], f[7]); return w; }

#define LOAD_RS8(rs, ss) float rs[2][4]; { float t_[2][4]; _Pragma("unroll") for (int ai = 0; ai < 2; ++ai) _Pragma("unroll") for (int mm = 0; mm < 4; ++mm) t_[ai][mm] = (ss)[u.pm * 256 + ai * 128 + wr * 64 + mm * 16 + fr]; \
    _Pragma("unroll") for (int ai = 0; ai < 2; ++ai) _Pragma("unroll") for (int mm = 0; mm < 4; ++mm) rs[ai][mm] = rstd_of(t_[ai][mm]); }
#define EPI_ROWS(...) _Pragma("unroll") for (int ai = 0; ai < 2; ++ai) _Pragma("unroll") for (int m = 0; m < 4; ++m) { const int row = u.pm * 256 + ai * 128 + wr * 64 + m * 16 + fr; __VA_ARGS__ asm volatile("" ::: "memory"); }
typedef const f32x4 (&AccRef)[2][2][4][2];

struct EpiStore {
    static constexpr bool PERM = true, AFTER_DRAIN = false;
    const float* ss; bf16_t* o0; int ld0; int split; bf16_t* o1; int ld1;
    __device__ __forceinline__ void operator()(AccRef acc, const pg8::Unit& u, int wr, int wc, int fr, int fq) const {
        asm volatile("" : "+v"(fr), "+v"(fq));
        const int colt = u.pn * 256; bf16_t* base; int ld, cb;
        if (colt < split) { base = o0; ld = ld0; cb = colt; } else { base = o1; ld = ld1; cb = colt - split; }
        const int col0 = cb + wc * 32 + 8 * fq;
        float rsv[2][4];
        if (ss) { LOAD_RS8(r8, ss) _Pragma("unroll") for (int ai = 0; ai < 2; ++ai) _Pragma("unroll") for (int mm = 0; mm < 4; ++mm) rsv[ai][mm] = r8[ai][mm]; }
        else { _Pragma("unroll") for (int ai = 0; ai < 2; ++ai) _Pragma("unroll") for (int mm = 0; mm < 4; ++mm) rsv[ai][mm] = 1.f; }
        EPI_ROWS(
            const float rs = rsv[ai][m]; bf16_t* rp = base + (size_t)row * ld + col0;
            _Pragma("unroll") for (int bj = 0; bj < 2; ++bj) { const f32x4 v0 = acc[ai][bj][m][0] * rs, v1 = acc[ai][bj][m][1] * rs;
                u32x4 w; w.x = pk2(v0[0], v0[1]); w.y = pk2(v0[2], v0[3]); w.z = pk2(v1[0], v1[1]); w.w = pk2(v1[2], v1[3]); *(u32x4*)(rp + bj * 128) = w; }
        )
    }
};
struct EpiKVQ {
    static constexpr bool PERM = true, AFTER_DRAIN = false;
    const float* ss; bf16_t* kv; bf16_t* proj; unsigned* kmax;
    __device__ __forceinline__ void operator()(AccRef acc, const pg8::Unit& u, int wr, int wc, int fr, int fq) const {
        asm volatile("" : "+v"(fr), "+v"(fq));
        const bool isq = u.pn >= 6; bf16_t* base = isq ? proj : kv; const int ld = isq ? 1024 : 1536, col0 = (isq ? u.pn * 256 - 1536 : u.pn * 256) + wc * 32 + 8 * fq;
        LOAD_RS8(rsv, ss)
        float mx[2] = {0.f, 0.f};
        EPI_ROWS(
            const float rs = rsv[ai][m]; bf16_t* rp = base + (size_t)row * ld + col0;
            _Pragma("unroll") for (int bj = 0; bj < 2; ++bj) { const f32x4 v0 = acc[ai][bj][m][0] * rs, v1 = acc[ai][bj][m][1] * rs;
                u32x4 w; w.x = pk2(v0[0], v0[1]); w.y = pk2(v0[2], v0[3]); w.z = pk2(v1[0], v1[1]); w.w = pk2(v1[2], v1[3]); __builtin_nontemporal_store(w, (u32x4*)(rp + bj * 128));
                if (u.pn < 3) { float sq = (v0[0] * v0[0] + v0[1] * v0[1]) + (v0[2] * v0[2] + v0[3] * v0[3]) + (v1[0] * v1[0] + v1[1] * v1[1]) + (v1[2] * v1[2] + v1[3] * v1[3]);
                    sq += __shfl_xor(sq, 16); sq += __shfl_xor(sq, 32); mx[bj] = fmaxf(mx[bj], sq); } }
        )
        if (u.pn < 3) {
#pragma unroll
            for (int bj = 0; bj < 2; ++bj) { float v = mx[bj];
#pragma unroll
                for (int o = 1; o < 16; o <<= 1) v = fmaxf(v, __shfl_xor(v, o));
                if (fr == 0 && fq == 0) { const int b = (u.pm * 256) >> 12, h = u.pn * 4 + bj * 2 + (wc >> 1);
                    __hip_atomic_fetch_max(kmax + (b * NHEAD + h) * 2 + (wc & 1), __float_as_uint(v), __ATOMIC_RELAXED, __HIP_MEMORY_SCOPE_AGENT); } }
        }
    }
};
struct EpiIn0 {
    static constexpr bool PERM = true, AFTER_DRAIN = false;
    const float* ss; bf16_t* A3; bf16_t* proj;
    __device__ __forceinline__ void operator()(AccRef acc, const pg8::Unit& u, int wr, int wc, int fr, int fq) const {
        asm volatile("" : "+v"(fr), "+v"(fq));
        const int colt = u.pn * 256;
        LOAD_RS8(rsv, ss)
        EPI_ROWS(
            const float rs = rsv[ai][m];
            _Pragma("unroll") for (int bj = 0; bj < 2; ++bj) { const f32x4 v0 = acc[ai][bj][m][0] * rs, v1 = acc[ai][bj][m][1] * rs;
                u32x4 w; w.x = pk2(v0[0], v0[1]); w.y = pk2(v0[2], v0[3]); w.z = pk2(v1[0], v1[1]); w.w = pk2(v1[2], v1[3]);
                const int col = colt + bj * 128 + wc * 32 + 8 * fq;
                bf16_t* dst = (colt < DTOK) ? A3 + ((size_t)((col >> 4) * 2048 + (row >> 4)) * 384 + (row & 15) * 16 + (col & 15)) : proj + (size_t)row * 1024 + col;
                *(u32x4*)dst = w; }
        )
    }
};
struct EpiS1 {
    static constexpr bool PERM = true, AFTER_DRAIN = false;
    float* sloc;
    __device__ __forceinline__ void operator()(AccRef acc, const pg8::Unit& u, int wr, int wc, int fr, int fq) const {
        asm volatile("" : "+v"(fr), "+v"(fq));
        EPI_ROWS( float* p = sloc + (size_t)row * 128 + wc * 32 + 8 * fq; *(f32x4*)p = acc[ai][0][m][0]; *(f32x4*)(p + 4) = acc[ai][0][m][1]; )
    }
};
struct EpiS3 {
    static constexpr bool PERM = true, AFTER_DRAIN = false;
    bf16_t* gb;
    __device__ __forceinline__ void operator()(AccRef acc, const pg8::Unit& u, int wr, int wc, int fr, int fq) const {
        asm volatile("" : "+v"(fr), "+v"(fq));
        const int g = u.pn;
        EPI_ROWS(
            const int rl = row & 2047;
            _Pragma("unroll") for (int bj = 0; bj < 2; ++bj) { const int colL = bj * 128 + wc * 32 + 8 * fq, s = colL >> 4, i0 = colL & 15;
                const f32x4 a0 = acc[ai][bj][m][0], a1 = acc[ai][bj][m][1]; u32x4 w;
                w.x = pk2(gelu_tanh(a0[0]), gelu_tanh(a0[1])); w.y = pk2(gelu_tanh(a0[2]), gelu_tanh(a0[3]));
                w.z = pk2(gelu_tanh(a1[0]), gelu_tanh(a1[1])); w.w = pk2(gelu_tanh(a1[2]), gelu_tanh(a1[3]));
                *(u32x4*)(gb + (size_t)(rl * 16 + s) * DTOK + g * 16 + i0) = w; }
        )
    }
};
struct EpiGlu {
    static constexpr bool PERM = true, AFTER_DRAIN = false;
    const bf16_t* gb; bf16_t* tokmix;
    __device__ __forceinline__ void operator()(AccRef acc, const pg8::Unit& u, int wr, int wc, int fr, int fq) const {
        asm volatile("" : "+v"(fr), "+v"(fq));
#pragma unroll
        for (int ai = 0; ai < 2; ++ai) {
            u32x4 gw[4][2];
#pragma unroll
            for (int m = 0; m < 4; ++m)
#pragma unroll
                for (int bj = 0; bj < 2; ++bj) gw[m][bj] = *(const u32x4*)(gb + (size_t)(u.pm * 256 + ai * 128 + wr * 64 + m * 16 + fr) * DTOK + u.pn * 256 + bj * 128 + wc * 32 + 8 * fq);
#pragma unroll
            for (int m = 0; m < 4; ++m)
#pragma unroll
                for (int bj = 0; bj < 2; ++bj) { const int row = u.pm * 256 + ai * 128 + wr * 64 + m * 16 + fr, col0 = u.pn * 256 + bj * 128 + wc * 32 + 8 * fq;
                    float gf[8]; unpack8(gw[m][bj], gf); const f32x4 a0 = acc[ai][bj][m][0], a1 = acc[ai][bj][m][1]; float y[8];
#pragma unroll
                    for (int j = 0; j < 4; ++j) { y[j] = gf[j] * sigm(a0[j]); y[4 + j] = gf[4 + j] * sigm(a1[j]); }
                    *(u32x4*)(tokmix + (size_t)row * 1024 + col0) = pack8(y); }
            asm volatile("" ::: "memory");
        }
    }
};
template <bool BASE_BF16, bool WRITE_F32>
struct EpiRes {
    static constexpr bool PERM = true, AFTER_DRAIN = false;
    const void* base; float* out; bf16_t* hb; float* ss;
    __device__ __forceinline__ void operator()(AccRef acc, const pg8::Unit& u, int wr, int wc, int fr, int fq) const {
        asm volatile("" : "+v"(fr), "+v"(fq));
#pragma unroll
        for (int ai = 0; ai < 2; ++ai) {
            f32x4 bv[4][2][2];
#pragma unroll
            for (int m = 0; m < 4; ++m)
#pragma unroll
                for (int bj = 0; bj < 2; ++bj) { const size_t off = (size_t)(u.pm * 256 + ai * 128 + wr * 64 + m * 16 + fr) * 1024 + u.pn * 256 + bj * 128 + wc * 32 + 8 * fq;
                    if (BASE_BF16) { const u32x4 w = *(const u32x4*)((const bf16_t*)base + off);
                        bv[m][bj][0] = (f32x4){bf_lo(w.x), bf_hi(w.x), bf_lo(w.y), bf_hi(w.y)}; bv[m][bj][1] = (f32x4){bf_lo(w.z), bf_hi(w.z), bf_lo(w.w), bf_hi(w.w)}; }
                    else { bv[m][bj][0] = *(const f32x4*)((const float*)base + off); bv[m][bj][1] = *(const f32x4*)((const float*)base + off + 4); } }
#pragma unroll
            for (int m = 0; m < 4; ++m) { const int row = u.pm * 256 + ai * 128 + wr * 64 + m * 16 + fr; float sq = 0.f;
#pragma unroll
                for (int bj = 0; bj < 2; ++bj) { const size_t off = (size_t)row * 1024 + u.pn * 256 + bj * 128 + wc * 32 + 8 * fq;
                    const f32x4 v0 = acc[ai][bj][m][0] + bv[m][bj][0], v1 = acc[ai][bj][m][1] + bv[m][bj][1];
                    if (WRITE_F32) { *(f32x4*)(out + off) = v0; *(f32x4*)(out + off + 4) = v1; }
                    if (hb) { u32x4 w; w.x = pk2(v0[0], v0[1]); w.y = pk2(v0[2], v0[3]); w.z = pk2(v1[0], v1[1]); w.w = pk2(v1[2], v1[3]); *(u32x4*)(hb + off) = w; }
                    sq += (v0[0] * v0[0] + v0[1] * v0[1]) + (v0[2] * v0[2] + v0[3] * v0[3]) + (v1[0] * v1[0] + v1[1] * v1[1]) + (v1[2] * v1[2] + v1[3] * v1[3]); }
                sq += __shfl_xor(sq, 16); sq += __shfl_xor(sq, 32);
                if (fq == 0) __hip_atomic_fetch_add(ss + row, sq, __ATOMIC_RELAXED, __HIP_MEMORY_SCOPE_AGENT); }
            asm volatile("" ::: "memory");
        }
    }
};
typedef EpiRes<true, false> EpiResMix;
typedef EpiRes<true, true> EpiResFfn;
struct EpiUpConv {
    static constexpr bool PERM = true, AFTER_DRAIN = false;
    const float* ss; bf16_t* act; const float* cw; const float* cb; float* ghead; float* gtail;
    __device__ __forceinline__ void operator()(AccRef acc, const pg8::Unit& u, int wr, int wc, int fr, int fq) const {
        asm volatile("" : "+v"(fr), "+v"(fq));
        const int ch0 = u.pn * 128 + wc * 32 + 8 * fq, tok0 = u.pm * 256 + wr * 128 + fr * 8, grp = tok0 >> 7;
        const bool seq0 = (tok0 & (SEQ - 1)) == 0, head = (fr == 0) && !seq0;
        const f32x4 rsa = *(const f32x4*)(ss + tok0), rsb = *(const f32x4*)(ss + tok0 + 4);
        float rs[8];
#pragma unroll
        for (int k = 0; k < 4; ++k) { rs[k] = rstd_of(rsa[k]); rs[4 + k] = rstd_of(rsb[k]); }
        unsigned ylo[8][2];
#pragma unroll
        for (int n = 0; n < 2; ++n) {
            const int ch = ch0 + 4 * n;
            const f32x4 w0 = *(const f32x4*)(cw + ch), w1 = *(const f32x4*)(cw + DFF + ch), w2 = *(const f32x4*)(cw + 2 * DFF + ch), bb = *(const f32x4*)(cb + ch);
            const f32x4 g6 = acc[1][1][2][n] * rs[6], g7 = acc[1][1][3][n] * rs[7];
            f32x4 gm2, gm1;
#pragma unroll
            for (int j = 0; j < 4; ++j) { gm2[j] = __shfl_up(g6[j], 1); gm1[j] = __shfl_up(g7[j], 1); }
            if (seq0) { gm2 = (f32x4){0.f, 0.f, 0.f, 0.f}; gm1 = gm2; }
            if (fr == 15) { *(f32x4*)(gtail + ((size_t)grp * 2 + 0) * DFF + ch) = g6; *(f32x4*)(gtail + ((size_t)grp * 2 + 1) * DFF + ch) = g7; }
#pragma unroll
            for (int k = 0; k < 8; ++k) {
                const f32x4 gk = acc[k >> 2][1][k & 3][n] * rs[k], ak = acc[k >> 2][0][k & 3][n] * rs[k];
                const f32x4 part = (k == 1) ? (w1 * gm1 + w2 * gk + bb) : (w2 * gk + bb);
                if (k < 2 && head) { *(f32x4*)(ghead + ((size_t)grp * 4 + k) * DFF + ch) = part; *(f32x4*)(ghead + ((size_t)grp * 4 + 2 + k) * DFF + ch) = ak; }
                const f32x4 gc = (k == 1) ? (part + w0 * gm2) : (part + w0 * gm2 + w1 * gm1);
                const unsigned p0 = pk2(gc[0] * sigm(gc[0]) * ak[0], gc[1] * sigm(gc[1]) * ak[1]), p1 = pk2(gc[2] * sigm(gc[2]) * ak[2], gc[3] * sigm(gc[3]) * ak[3]);
                if (n == 0) { ylo[k][0] = p0; ylo[k][1] = p1; }
                else { u32x4 w; w.x = ylo[k][0]; w.y = ylo[k][1]; w.z = p0; w.w = p1; __builtin_nontemporal_store(w, (u32x4*)(act + (size_t)(tok0 + k) * DFF + ch0)); }
                gm2 = gm1; gm1 = gk;
            }
        }
    }
};
struct GroupOrder {
    int G, c;
    __device__ __forceinline__ bool next(int i, pg8::Unit& u) const { const int L = i * G + c; if (L >= NGRP * 8) return false; u.pm = L; u.pn = L >> 3; return true; }
    __device__ __forceinline__ void a_ready(const pg8::Unit&) const {}
    __device__ __forceinline__ void done(const pg8::Unit&) const {}
};

__device__ __forceinline__ void tr_item(const float* __restrict__ W, int K, int N, bf16_t* __restrict__ dst, const float* __restrict__ gk, int cs_from, int mode, int row_off,
                                        LAS float* scr, int item, int lane) {
    const int nblk = N / 64, kb = item / nblk, nb = item - kb * nblk, k0 = 32 * kb, n0 = 64 * nb;
    const int lk = lane >> 4, ln = (lane & 15) * 4;
    f32x4 v[8];
#pragma unroll
    for (int i = 0; i < 8; ++i) v[i] = __builtin_nontemporal_load((const f32x4*)(W + (size_t)(k0 + 4 * i + lk) * N + n0 + ln));
    if (gk) {
#pragma unroll
        for (int i = 0; i < 8; ++i) v[i] = v[i] * gk[k0 + 4 * i + lk];
    }
#pragma unroll
    for (int i = 0; i < 8; ++i) { LAS float* s = scr + (4 * i + lk) * 65 + ln; s[0] = v[i][0]; s[1] = v[i][1]; s[2] = v[i][2]; s[3] = v[i][3]; }
    asm volatile("s_waitcnt lgkmcnt(0)" ::: "memory");
    const float csc = (n0 >= cs_from) ? C2 : 1.f;
    int drow0;
    if (mode == 1) { drow0 = (n0 < DFF) ? 256 * (n0 >> 7) + (n0 & 127) : 256 * ((n0 - DFF) >> 7) + 128 + ((n0 - DFF) & 127); } else drow0 = row_off + n0;
    const int c = lane & 3;
#pragma unroll
    for (int j = 0; j < 4; ++j) { const int n = (lane >> 2) + 16 * j; const LAS float* s = scr + (8 * c) * 65 + n;
        u32x4 o; o.x = pk2(s[0] * csc, s[65] * csc); o.y = pk2(s[130] * csc, s[195] * csc); o.z = pk2(s[260] * csc, s[325] * csc); o.w = pk2(s[390] * csc, s[455] * csc);
        *(u32x4*)(dst + (size_t)(drow0 + n) * K + k0 + 8 * c) = o; }
    asm volatile("s_waitcnt lgkmcnt(0)" ::: "memory");
}

__device__ __forceinline__ void s5_tables(const float* a_re, const float* a_im, const float* log_dt, const float* b_re, const float* b_im, const float* c_re, const float* c_im, const float* s5d,
                                          bf16_t* Bt1, bf16_t* Bt3, LAS float* L, int g, int part, int tid) {
    LAS float* Are = L; LAS float* Aim = L + 1088; LAS float* Bre = L + 2176; LAS float* Bim = L + 3200; LAS float* Cre = L + 4224; LAS float* Cim = L + 5248; LAS float* Kt = L + 6272;
    if (tid < 64) {
        const int p = tid; const float dt = fexp(log_dt[g]); const float lr = fminf(a_re[g * 64 + p], -1e-4f), li = a_im[g * 64 + p];
        for (int k = 0; k <= 16; ++k) { const float mag = fexp(lr * dt * (float)k); float rev = li * dt * (float)k * INV2PI; rev -= rintf(rev);
            Are[k * 64 + p] = mag * __builtin_amdgcn_cosf(rev); Aim[k * 64 + p] = mag * __builtin_amdgcn_sinf(rev); }
        const float abr = Are[64 + p], abi = Aim[64 + p], den = lr * lr + li * li;
        const float zr = ((abr - 1.f) * lr + abi * li) / den, zi = (abi * lr - (abr - 1.f) * li) / den;
        for (int j = 0; j < 16; ++j) { const float br = b_re[(g * 64 + p) * 16 + j], bi = b_im[(g * 64 + p) * 16 + j]; Bre[p * 16 + j] = zr * br - zi * bi; Bim[p * 16 + j] = zr * bi + zi * br; }
    }
    for (int e = tid; e < 1024; e += NTHREADS) { Cre[e] = c_re[g * 1024 + e]; Cim[e] = c_im[g * 1024 + e]; }
    __syncthreads();
    if (part == 0) {
    for (int q = 0; q < 8; ++q) { const int e = tid + NTHREADS * q, k = e >> 8, i = (e >> 4) & 15, j = e & 15; float acc = 0.f;
        for (int p = 0; p < 64; ++p) { const float ar = Are[k * 64 + p], ai = Aim[k * 64 + p], br = Bre[p * 16 + j], bi = Bim[p * 16 + j];
            acc += Cre[i * 64 + p] * (ar * br - ai * bi) - Cim[i * 64 + p] * (ar * bi + ai * br); }
        Kt[e] = acc; }
    __syncthreads();
    for (int idx = tid; idx < 256 * 256; idx += NTHREADS) { const int n = idx >> 8, k = idx & 255, s = n >> 4, i = n & 15, r = k >> 4, j = k & 15;
        float v = (s >= r) ? Kt[((s - r) * 16 + i) * 16 + j] : 0.f; if (s == r && i == j) v += s5d[g * 16 + i];
        Bt3[(size_t)(g * 256 + n) * 384 + k] = f2bf(v); }
    } else {
    for (int idx = tid; idx < 256 * 128; idx += NTHREADS) { const int n = idx >> 7, k = 256 + (idx & 127), s = n >> 4, i = n & 15; float v;
        if (k < 320) { const int p = k - 256; v = Cre[i * 64 + p] * Are[(s + 1) * 64 + p] - Cim[i * 64 + p] * Aim[(s + 1) * 64 + p]; }
        else { const int p = k - 320; v = -(Cre[i * 64 + p] * Aim[(s + 1) * 64 + p] + Cim[i * 64 + p] * Are[(s + 1) * 64 + p]); }
        Bt3[(size_t)(g * 256 + n) * 384 + k] = f2bf(v); }
    for (int idx = tid; idx < 65536; idx += NTHREADS) { const int n = idx >> 8, k = idx & 255, r = k >> 4, j = k & 15; float v = 0.f;
        if (n < 64) { const int p = n; v = Are[(15 - r) * 64 + p] * Bre[p * 16 + j] - Aim[(15 - r) * 64 + p] * Bim[p * 16 + j]; }
        else if (n < 128) { const int p = n - 64; v = Are[(15 - r) * 64 + p] * Bim[p * 16 + j] + Aim[(15 - r) * 64 + p] * Bre[p * 16 + j]; }
        Bt1[(size_t)(g * 256 + n) * 256 + k] = f2bf(v); }
    }
    __syncthreads();
}

__device__ __forceinline__ void s5_scan_item(const float* a_re, const float* a_im, const float* log_dt, const float* __restrict__ sloc, bf16_t* __restrict__ A3, int item, int lane) {
    const int g = item >> 3, b = item & 7, p = lane;
    const float dt = fexp(log_dt[g]); const float lr = fminf(a_re[g * 64 + p], -1e-4f), li = a_im[g * 64 + p];
    const float mag = fexp(lr * dt * 16.f); float rev = li * dt * 16.f * INV2PI; rev -= rintf(rev);
    const float ar = mag * __builtin_amdgcn_cosf(rev), ai = mag * __builtin_amdgcn_sinf(rev);
    float hr = 0.f, hi = 0.f; const size_t row0 = (size_t)g * 2048 + b * 256;
    float sr[16], si[16], nr[16], ni[16];
#define SCAN_LOAD(dr, di, c0) _Pragma("unroll") for (int q = 0; q < 16; ++q) { dr[q] = sloc[(row0 + (c0) + q) * 128 + p]; di[q] = sloc[(row0 + (c0) + q) * 128 + 64 + p]; }
#define SCAN_STEP(xr, xi, c0) _Pragma("unroll") for (int q = 0; q < 16; ++q) { bf16_t* a = A3 + (row0 + (c0) + q) * 384 + 256 + p; a[0] = f2bf(hr); a[64] = f2bf(hi); \
            const float t = ar * hr - ai * hi + xr[q]; hi = ar * hi + ai * hr + xi[q]; hr = t; }
    SCAN_LOAD(sr, si, 0)
#pragma unroll 1
    for (int c0 = 0; c0 < 256; c0 += 32) {
        SCAN_LOAD(nr, ni, c0 + 16)
        SCAN_STEP(sr, si, c0)
        if (c0 + 32 < 256) { SCAN_LOAD(sr, si, c0 + 32) }
        SCAN_STEP(nr, ni, c0 + 16)
    }
#undef SCAN_LOAD
#undef SCAN_STEP
}

__device__ __forceinline__ void convfix_panel(bf16_t* __restrict__ act, const float* __restrict__ ghead, const float* __restrict__ gtail, const float* __restrict__ cw, int pm, int tid) {
    for (int idx = tid; idx < 2 * 352; idx += NTHREADS) {
        const int grp = 2 * pm + idx / 352, ch = (idx % 352) * 8;
        if ((grp & 31) == 0) continue;
        unsigned o0[4], o1[4];
#pragma unroll
        for (int hh = 0; hh < 2; ++hh) { const int c = ch + 4 * hh;
            const f32x4 P0 = *(const f32x4*)(ghead + ((size_t)grp * 4 + 0) * DFF + c), P1 = *(const f32x4*)(ghead + ((size_t)grp * 4 + 1) * DFF + c);
            const f32x4 a0 = *(const f32x4*)(ghead + ((size_t)grp * 4 + 2) * DFF + c), a1 = *(const f32x4*)(ghead + ((size_t)grp * 4 + 3) * DFF + c);
            const f32x4 T6 = *(const f32x4*)(gtail + ((size_t)(grp - 1) * 2 + 0) * DFF + c), T7 = *(const f32x4*)(gtail + ((size_t)(grp - 1) * 2 + 1) * DFF + c);
            const f32x4 w0 = *(const f32x4*)(cw + c), w1 = *(const f32x4*)(cw + DFF + c);
            const f32x4 c0 = P0 + w0 * T6 + w1 * T7, c1 = P1 + w0 * T7;
            o0[2 * hh] = pk2(c0[0] * sigm(c0[0]) * a0[0], c0[1] * sigm(c0[1]) * a0[1]); o0[2 * hh + 1] = pk2(c0[2] * sigm(c0[2]) * a0[2], c0[3] * sigm(c0[3]) * a0[3]);
            o1[2 * hh] = pk2(c1[0] * sigm(c1[0]) * a1[0], c1[1] * sigm(c1[1]) * a1[1]); o1[2 * hh + 1] = pk2(c1[2] * sigm(c1[2]) * a1[2], c1[3] * sigm(c1[3]) * a1[3]); }
        u32x4 w; w.x = o0[0]; w.y = o0[1]; w.z = o0[2]; w.w = o0[3]; *(u32x4*)(act + (size_t)(grp * 128) * DFF + ch) = w;
        w.x = o1[0]; w.y = o1[1]; w.z = o1[2]; w.w = o1[3]; *(u32x4*)(act + (size_t)(grp * 128 + 1) * DFF + ch) = w;
    }
}

__device__ __forceinline__ void fgate_phase(const bf16_t* __restrict__ h, const float* __restrict__ ss, const float* __restrict__ wf, const float* __restrict__ gkv, const float* __restrict__ bfg,
                                            float* __restrict__ logf, LAS float* L, int tid, int wid, int lane) {
#pragma unroll 4
    for (int rec = tid; rec < 1024; rec += NTHREADS) { const int k = 256 * (rec >> 8) + 4 * (rec & 63) + ((rec >> 6) & 3); const float gk = gkv[k];
        const f32x4 a = *(const f32x4*)(wf + k * 12), b = *(const f32x4*)(wf + k * 12 + 4), c = *(const f32x4*)(wf + k * 12 + 8);
        LAS f32x4* d = (LAS f32x4*)(L + rec * 12); d[0] = a * gk; d[1] = b * gk; d[2] = c * gk; }
    __syncthreads();
    const LAS f32x4* L4 = (const LAS f32x4*)L;
    typedef unsigned u32x2_t __attribute__((ext_vector_type(2)));
    const int rstep = gridDim.x * NWAVES * 2; int r0 = (blockIdx.x * NWAVES + wid) * 2;
    u32x2_t hw[2][4], hn[2][4];
    { const int rc = r0 < NTOK ? r0 : 0;
#pragma unroll
      for (int r = 0; r < 2; ++r)
#pragma unroll
          for (int i = 0; i < 4; ++i) hw[r][i] = *(const u32x2_t*)(h + (size_t)(rc + r) * 1024 + 256 * i + 4 * lane); }
#pragma unroll 1
    for (; r0 < NTOK; r0 += rstep) {
        { const int rn = r0 + rstep < NTOK ? r0 + rstep : r0;
#pragma unroll
          for (int r = 0; r < 2; ++r)
#pragma unroll
              for (int i = 0; i < 4; ++i) hn[r][i] = *(const u32x2_t*)(h + (size_t)(rn + r) * 1024 + 256 * i + 4 * lane); }
        f32x4 hv[2][4];
#pragma unroll
        for (int r = 0; r < 2; ++r)
#pragma unroll
            for (int i = 0; i < 4; ++i) hv[r][i] = (f32x4){bf_lo(hw[r][i].x), bf_hi(hw[r][i].x), bf_lo(hw[r][i].y), bf_hi(hw[r][i].y)};
        float acc[2][12];
#pragma unroll
        for (int r = 0; r < 2; ++r)
#pragma unroll
            for (int q = 0; q < 12; ++q) acc[r][q] = 0.f;
#pragma unroll
        for (int i = 0; i < 4; ++i)
#pragma unroll
            for (int e = 0; e < 4; ++e) { const int rec = (i * 4 + e) * 64 + lane; const f32x4 wa = L4[rec * 3], wb = L4[rec * 3 + 1], wc4 = L4[rec * 3 + 2];
#pragma unroll
                for (int r = 0; r < 2; ++r) { const float x = hv[r][i][e];
                    acc[r][0] += x * wa[0]; acc[r][1] += x * wa[1]; acc[r][2] += x * wa[2]; acc[r][3] += x * wa[3];
                    acc[r][4] += x * wb[0]; acc[r][5] += x * wb[1]; acc[r][6] += x * wb[2]; acc[r][7] += x * wb[3];
                    acc[r][8] += x * wc4[0]; acc[r][9] += x * wc4[1]; acc[r][10] += x * wc4[2]; acc[r][11] += x * wc4[3]; }
                if ((e & 1) == 1) __builtin_amdgcn_sched_barrier(0); }
        float z = 0.f;
#pragma unroll
        for (int r = 0; r < 2; ++r)
#pragma unroll
            for (int q = 0; q < 12; ++q) { const float v = wave_sum(acc[r][q]); if (lane == r * 12 + q) z = v; }
        if (lane < 24) { const int r = lane / 12, q = lane - r * 12, row = r0 + r;
            z = z * rstd_of(ss[row]) + bfg[q];
            const float lf = fminf(z, 0.f) - __logf(1.f + fexp(-fabsf(z)));
            logf[(size_t)((row >> 12) * NHEAD + q) * SEQ + (row & (SEQ - 1))] = lf; }
#pragma unroll
        for (int r = 0; r < 2; ++r)
#pragma unroll
            for (int i = 0; i < 4; ++i) hw[r][i] = hn[r][i];
    }
    __syncthreads();
}

__device__ __forceinline__ void build_btab(const float* __restrict__ lf, LAS float* btab, LAS float* wsum, int tid, int wid, int lane) {
    __syncthreads();
    const f32x4 a = *(const f32x4*)(lf + 8 * tid), b = *(const f32x4*)(lf + 8 * tid + 4);
    float p[8]; p[0] = a[0]; p[1] = p[0] + a[1]; p[2] = p[1] + a[2]; p[3] = p[2] + a[3]; p[4] = p[3] + b[0]; p[5] = p[4] + b[1]; p[6] = p[5] + b[2]; p[7] = p[6] + b[3];
    float x = p[7];
#pragma unroll
    for (int o = 1; o < 64; o <<= 1) { const float n = __shfl_up(x, o); if (lane >= o) x += n; }
    if (lane == 63) wsum[wid] = x;
    __syncthreads();
    float off = x - p[7];
    for (int w = 0; w < wid; ++w) off += wsum[w];
    f32x4 o0, o1;
    o0[0] = -(off + p[0]) * LOG2E; o0[1] = -(off + p[1]) * LOG2E; o0[2] = -(off + p[2]) * LOG2E; o0[3] = -(off + p[3]) * LOG2E;
    o1[0] = -(off + p[4]) * LOG2E; o1[1] = -(off + p[5]) * LOG2E; o1[2] = -(off + p[6]) * LOG2E; o1[3] = -(off + p[7]) * LOG2E;
    *(LAS f32x4*)(btab + 8 * tid) = o0; *(LAS f32x4*)(btab + 8 * tid + 4) = o1;
    __syncthreads();
}

__device__ __forceinline__ void mem_attn_phase(const bf16_t* proj, const bf16_t* memkv, bf16_t* tokmix, char* lds, int n_light, int lu) {
    const int NU = NB * 4 * 16, G = gridDim.x, bx = blockIdx.x;
    int u0, u1, ust;
    if (n_light > 0 && n_light < G && n_light * lu < NU) { const int nl = n_light * lu, per = (NU - nl + (G - n_light) - 1) / (G - n_light);
        if (bx < n_light) { u0 = bx * lu; u1 = u0 + lu; } else { u0 = nl + (bx - n_light) * per; u1 = u0 + per < NU ? u0 + per : NU; } ust = 1; }
    else { u0 = bx; u1 = NU; ust = G; }
    for (int ui = u0; ui < u1; ui += ust) {
        const int b = ui >> 6, h = (ui >> 4) & 3, qb = ui & 15;
        const size_t qoff = (size_t)(b * SEQ + qb * 256) * 1024 + DTOK + h * 64;
        const bf16_t* K = memkv + (size_t)(b * MEMT) * 512 + h * 64;
        attn_body::attn_unit<8, false, false, 1024, 512>((const abf16*)(proj + qoff), (const abf16*)K, (const abf16*)(K + 256), (abf16*)(tokmix + qoff), 4, (attn_body::lds_f4p)nullptr, lds);
    }
}
__device__ __forceinline__ void fox_attn_phase(const bf16_t* proj, const bf16_t* kv, bf16_t* tokmix, const float* logf, const unsigned* kmax, unsigned* ctr, char* lds, LAS unsigned char* ldsl, int tid, int wid, int lane) {
    int last_bh = -1;
    LAS float* btab = (LAS float*)(ldsl + LDS_BTAB); LAS float* wsum = (LAS float*)(ldsl + LDS_WSUM); volatile LAS unsigned* nxt = (volatile LAS unsigned*)(ldsl + LDS_WSUM + 128);
#pragma unroll 1
    for (;;) {
        __syncthreads();
        if (tid == 0) nxt[0] = __hip_atomic_fetch_add(ctr, 1u, __ATOMIC_RELAXED, __HIP_MEMORY_SCOPE_AGENT);
        __syncthreads();
        const int ui = (int)nxt[0];
        if (ui >= NB * NHEAD * 16) break;
        const int qb = 15 - ui / (NB * NHEAD), bh = ui % (NB * NHEAD), b = bh / NHEAD, h = bh - b * NHEAD;
        if (bh != last_bh) { build_btab(logf + (size_t)bh * SEQ, btab, wsum, tid, wid, lane); last_bh = bh; }
        const bf16_t* K = kv + (size_t)(b * SEQ) * 1536 + h * 64;
        const size_t qoff = (size_t)(b * SEQ + qb * 256) * 1024 + h * 64;
        const float kmv = 1.01f * sqrtf(__uint_as_float(kmax[bh * 2]) + __uint_as_float(kmax[bh * 2 + 1]));
        attn_body::attn_unit<8, true, true, 1024, 1536, true, true>((const abf16*)(proj + qoff), (const abf16*)K, (const abf16*)(K + DTOK), (abf16*)(tokmix + qoff), 4 * qb + 4, (attn_body::lds_f4p)btab, lds, kmv, (LAS float*)(ldsl + LDS_WSUM + 64));
    }
}

#define XB_TMO      128
#define XB_XCNT(j)  (256  + 64 * (j))
#define XB_XSUB(j)  (1280 + 64 * (j))
#define XB_XGEN(j)  (2304 + 64 * (j))
#define XB_TOP      3328
#define XB_TOPGEN   3392
#define XCD_BAR_WORDS 3456
#define XB_SPIN_CAP (1u << 18)

__device__ __forceinline__ unsigned xb_ld(unsigned* p)              { return __hip_atomic_load(p, __ATOMIC_RELAXED, __HIP_MEMORY_SCOPE_AGENT); }
__device__ __forceinline__ unsigned xb_add(unsigned* p, unsigned v) { return __hip_atomic_fetch_add(p, v, __ATOMIC_RELAXED, __HIP_MEMORY_SCOPE_AGENT); }
__device__ __forceinline__ unsigned xb_xcc_id() { return (unsigned)__builtin_amdgcn_s_getreg((3 << 11) | 20) & 0xFu; }
#define XB_SPIN(cond, bar) do { unsigned _sp = 0; while (cond) { __builtin_amdgcn_s_sleep(1); \
    if ((++_sp & 255u) == 0u) { if (xb_ld(&(bar)[XB_TMO])) break; if (_sp > XB_SPIN_CAP) { atomicAdd(&(bar)[XB_TMO], 1u); break; } } } } while (0)

struct XcdBarrier {
    unsigned* bar; unsigned x;
    volatile LAS unsigned* st;
};

__device__ __forceinline__ XcdBarrier xcd_barrier_post(unsigned* bar, volatile LAS unsigned* st) {
    XcdBarrier b; b.bar = bar; b.x = xb_xcc_id(); b.st = st;
    if (threadIdx.x == 0) (void)xb_add(&bar[XB_XCNT(b.x)], 1u);
    return b;
}
__device__ __forceinline__ void xcd_barrier_complete(unsigned* bar, unsigned x, unsigned& nloc, unsigned& nx) {
    const unsigned G = gridDim.x * gridDim.y * gridDim.z;
    unsigned sum, cnt, mine, sp = 0u;
    for (;;) {
        sum = 0u; cnt = 0u; mine = 0u;
#pragma unroll
        for (unsigned j = 0; j < 16; ++j) { const unsigned c = xb_ld(&bar[XB_XCNT(j)]); sum += c; cnt += (c > 0u) ? 1u : 0u; mine = (j == x) ? c : mine; }
        if (sum == G) break;
        __builtin_amdgcn_s_sleep(1);
        if ((++sp & 255u) == 0u) { if (xb_ld(&bar[XB_TMO])) break; if (sp > XB_SPIN_CAP) { atomicAdd(&bar[XB_TMO], 1u); break; } }
    }
    nloc = mine > 0u ? mine : 1u; nx = cnt > 0u ? cnt : 1u;
}

__device__ __forceinline__ void xcd_barrier(const XcdBarrier& b) {
    asm volatile("s_waitcnt vmcnt(0)" ::: "memory");
    __syncthreads();
    if (threadIdx.x == 0) {
        unsigned* bar = b.bar;
        __builtin_amdgcn_s_waitcnt(0);
        unsigned nloc = b.st[0], nx = b.st[1];
        if (nloc == 0u) { xcd_barrier_complete(bar, b.x, nloc, nx); b.st[0] = nloc; b.st[1] = nx; }
        const unsigned old = xb_add(&bar[XB_XSUB(b.x)], 1u);
        const unsigned gen = old / nloc;
        if (old + 1u == (gen + 1u) * nloc) {
            __builtin_amdgcn_fence(__ATOMIC_RELEASE, "agent");
            asm volatile("s_waitcnt vmcnt(0)" ::: "memory");
            const unsigned og = xb_add(&bar[XB_TOP], 1u);
            const unsigned tg = og / nx;
            if (og + 1u == (tg + 1u) * nx) xb_add(&bar[XB_TOPGEN], 1u);
            else XB_SPIN(xb_ld(&bar[XB_TOPGEN]) == tg, bar);
            __builtin_amdgcn_fence(__ATOMIC_ACQUIRE, "agent");
            xb_add(&bar[XB_XGEN(b.x)], 1u);
            asm volatile("s_waitcnt vmcnt(0)" ::: "memory");
        } else {
            XB_SPIN(xb_ld(&bar[XB_XGEN(b.x)]) == gen, bar);
            __builtin_amdgcn_fence(__ATOMIC_ACQUIRE, "agent");
            asm volatile("s_waitcnt vmcnt(0)" ::: "memory");
        }
    }
    __syncthreads();
}

struct Args { const float* in[26]; float* out; unsigned char* ws; };
#define GEMM_CALL(EpiT, OrdT, g, S, E) pg8::gemm_phase<EpiT, OrdT, true, true>(ldsl, g, S, E)

__global__ void __launch_bounds__(NTHREADS, 2) fwd_megakernel(Args a) {
    extern __shared__ __attribute__((aligned(16))) unsigned char lds[];
    cg::grid_group grid = cg::this_grid();
    LAS unsigned char* ldsl = (LAS unsigned char*)lds;
#define TIDS() int tid_o = threadIdx.x; asm volatile("" : "+v"(tid_o)); const int tid = tid_o, lane = tid & 63, wid = __builtin_amdgcn_readfirstlane(tid >> 6); (void)lane; (void)wid
    const int G = gridDim.x, bx = blockIdx.x;
    unsigned* barw = (unsigned*)(a.ws + WS_BAR); volatile LAS unsigned* bst = (volatile LAS unsigned*)(ldsl + LDS_BYTES - 64);
    if (threadIdx.x < 2) bst[threadIdx.x] = 0u;
    unsigned char* ws = a.ws;
    const float* x = a.in[0]; float* out = a.out;
    float* ss = (float*)(ws + WS_SS); float* logf = (float*)(ws + WS_LOGF); unsigned* kmaxp = (unsigned*)(ws + WS_KMAX);
    bf16_t* hb = (bf16_t*)(ws + WS_HB);
    bf16_t* WIN0 = (bf16_t*)(ws + WS_WIN0); bf16_t* WGLU = (bf16_t*)(ws + WS_WGLU); bf16_t* WKVQ = (bf16_t*)(ws + WS_WKVQ);
    bf16_t* BT1 = (bf16_t*)(ws + WS_BT1); bf16_t* BT3 = (bf16_t*)(ws + WS_BT3); bf16_t* memn = (bf16_t*)(ws + WS_MEMN);
    bf16_t* A3 = (bf16_t*)(ws + WS_A3); float* sloc = (float*)(ws + WS_SLOC); bf16_t* gb = (bf16_t*)(ws + WS_GB); bf16_t* tokmix = (bf16_t*)(ws + WS_TOKMIX);
    bf16_t* abuf = (bf16_t*)(ws + WS_ABUF); float* ghead = (float*)(ws + WS_GBUF); float* gtail = (float*)(ws + WS_GBUF + 16 * MiB); bf16_t* kvb = (bf16_t*)(ws + WS_KV);
    bf16_t* proj0 = (bf16_t*)(ws + WS_PROJ0); bf16_t* proj1 = (bf16_t*)(ws + WS_PROJ1);

    constexpr int I_SQ = 16 * 32, I_UP = 16 * 176, I_DN = 44 * 32, I_GLU = 12 * 24, I_KV = 16 * 48, I_MKV = 16 * 16, BIG = 1 << 30, NTB = 2 * NGRP;
    {
        TIDS();
        if (bx == 0) for (int i = tid; i < XCD_BAR_WORDS; i += NTHREADS) barw[i] = 0u;
        if (bx == 0 && tid < NB * NHEAD * 2) kmaxp[tid] = 0u;
        if (bx == 0 && tid == 0) kmaxp[1024] = 0u;
        const bool split = G > NTB;
        for (int tb = bx; tb < NTB; tb += G) s5_tables(a.in[7], a.in[8], a.in[9], a.in[10], a.in[11], a.in[12], a.in[13], a.in[14], BT1, BT3, (LAS float*)ldsl, tb >> 1, tb & 1, tid);
        if (!split || bx >= NTB) {
            LAS float* scr = (LAS float*)(ldsl + wid * 16384);
            const int gw = (split ? bx - NTB : bx) * NWAVES + wid, NGW = (split ? G - NTB : G) * NWAVES;
            for (int it = gw; it < I_SQ + 2 * I_MKV; it += NGW) {
                int r = it;
                if (r < I_SQ) { tr_item(a.in[3], 1024, 1024, WIN0, a.in[2], DTOK, 0, 0, scr, r, lane); continue; } r -= I_SQ;
                if (r < I_MKV) { tr_item(a.in[6], 1024, 512, (bf16_t*)(ws + WS_WMKV0), nullptr, BIG, 0, 0, scr, r, lane); continue; } r -= I_MKV;
                tr_item(a.in[6] + 1024 * 512, 1024, 512, (bf16_t*)(ws + WS_WMKV1), nullptr, BIG, 0, 0, scr, r, lane);
            }
#pragma unroll 1
            for (int m = gw * 4; m < NTOK; m += NGW * 4) {
                const f32x4* xr = (const f32x4*)(x + (size_t)m * 1024) + lane; f32x4 v[16]; float s4[4];
#pragma unroll
                for (int j = 0; j < 16; ++j) v[j] = __builtin_nontemporal_load(xr + 64 * j);
#pragma unroll
                for (int r = 0; r < 4; ++r) { float s = 0.f;
#pragma unroll
                    for (int j = 0; j < 4; ++j) { const f32x4 t = v[4 * r + j]; s += (t[0] * t[0] + t[1] * t[1]) + (t[2] * t[2] + t[3] * t[3]); }
                    s4[r] = wave_sum(s); }
                if (lane == 0) { ss[m] = s4[0]; ss[m + 1] = s4[1]; ss[m + 2] = s4[2]; ss[m + 3] = s4[3]; }
                unsigned long long* o8 = (unsigned long long*)(hb + (size_t)m * 1024) + lane;
#pragma unroll
                for (int j = 0; j < 16; ++j) o8[64 * j] = (unsigned long long)pk2(v[j][0], v[j][1]) | ((unsigned long long)pk2(v[j][2], v[j][3]) << 32);
            }
            for (int m = gw; m < NB * MEMT; m += NGW) {
                const f32x4* xr = (const f32x4*)(a.in[1] + (size_t)m * 1024) + lane; const f32x4* gr = (const f32x4*)a.in[5] + lane; f32x4 v[4]; float s = 0.f;
#pragma unroll
                for (int j = 0; j < 4; ++j) { v[j] = xr[64 * j]; s += (v[j][0] * v[j][0] + v[j][1] * v[j][1]) + (v[j][2] * v[j][2] + v[j][3] * v[j][3]); }
                const float rs = rstd_of(wave_sum(s));
                unsigned long long* o8 = (unsigned long long*)(memn + (size_t)m * 1024) + lane;
#pragma unroll
                for (int j = 0; j < 4; ++j) { const f32x4 gg = gr[64 * j]; o8[64 * j] = (unsigned long long)pk2(v[j][0] * rs * gg[0], v[j][1] * rs * gg[1]) | ((unsigned long long)pk2(v[j][2] * rs * gg[2], v[j][3] * rs * gg[3]) << 32); }
            }
            for (int i = gw * 64 + lane; i < 4 * NTOK; i += NGW * 64) ss[NTOK + i] = 0.f;
        }
    }
    grid.sync();
    const XcdBarrier xbar = xcd_barrier_post(barw, bst);
#define SEAM() xcd_barrier(xbar)

    {
        pg8::Gemm g{hb, WIN0, NTOK, 1024, 1024, 1024, 1024}; pg8::StaticOrder S; S.init(NTOK, 1024, G, bx);
        EpiIn0 E{ss, A3, proj0}; GEMM_CALL(EpiIn0, pg8::StaticOrder, g, S, E);
    }
    SEAM();
    {
        GroupOrder S{G, bx};
        { pg8::Gemm g{A3, BT1, NGRP * 2048, NGRP * 256, 256, 384, 256}; EpiS1 E{sloc}; GEMM_CALL(EpiS1, GroupOrder, g, S, E); }
        asm volatile("s_waitcnt vmcnt(0)" ::: "memory"); __syncthreads(); __builtin_amdgcn_fence(__ATOMIC_ACQUIRE, "agent");
        {
            TIDS();
            if (wid < 2) { for (int item = wid * G + bx; item < NGRP * NB; item += G * 2) s5_scan_item(a.in[7], a.in[8], a.in[9], sloc, A3, item, lane); }
        else {
            LAS float* scr = (LAS float*)(ldsl + wid * 16384);
            constexpr int NLATE = 3 * I_SQ + 2 * I_UP + 2 * I_DN + I_GLU + I_KV;
            const int n2 = (NGRP * NB > G) ? ((NGRP * NB - G < G) ? NGRP * NB - G : G) : 0;
            const int nslots = 6 * n2 + 12 * (G - n2), slot0 = (bx < n2) ? 6 * bx + (wid - 2) : 6 * n2 + 12 * (bx - n2) + (wid - 2), nmine = (bx < n2) ? 1 : 2;
            for (int sl = 0; sl < nmine; ++sl)
            for (int it = slot0 + 6 * sl; it < NLATE; it += nslots) {
                int r = it;
                if (r < I_GLU) { tr_item(a.in[15], DTOK, DTOK, WGLU, nullptr, BIG, 0, 0, scr, r, lane); continue; } r -= I_GLU;
                if (r < I_SQ) { tr_item(a.in[4], 1024, 1024, (bf16_t*)(ws + WS_WOUT0), nullptr, BIG, 0, 0, scr, r, lane); continue; } r -= I_SQ;
                if (r < I_UP) { tr_item(a.in[21], 1024, 2 * DFF, (bf16_t*)(ws + WS_WUP0), a.in[20], BIG, 1, 0, scr, r, lane); continue; } r -= I_UP;
                if (r < I_DN) { tr_item(a.in[24], DFF, 1024, (bf16_t*)(ws + WS_WDN0), nullptr, BIG, 0, 0, scr, r, lane); continue; } r -= I_DN;
                if (r < I_KV) { tr_item(a.in[17], 1024, 1536, WKVQ, a.in[16], BIG, 0, 0, scr, r, lane); continue; } r -= I_KV;
                if (r < I_SQ) { tr_item(a.in[3] + 1024 * 1024, 1024, 1024, WKVQ, a.in[2] + 1024, 0, 0, 1536, scr, r, lane); continue; } r -= I_SQ;
                if (r < I_SQ) { tr_item(a.in[4] + 1024 * 1024, 1024, 1024, (bf16_t*)(ws + WS_WOUT1), nullptr, BIG, 0, 0, scr, r, lane); continue; } r -= I_SQ;
                if (r < I_UP) { tr_item(a.in[21] + (size_t)1024 * 2 * DFF, 1024, 2 * DFF, (bf16_t*)(ws + WS_WUP1), a.in[20] + 1024, BIG, 1, 0, scr, r, lane); continue; } r -= I_UP;
                tr_item(a.in[24] + (size_t)DFF * 1024, DFF, 1024, (bf16_t*)(ws + WS_WDN1), nullptr, BIG, 0, 0, scr, r, lane);
            }
        }
        }
        asm volatile("s_waitcnt vmcnt(0)" ::: "memory"); __syncthreads(); __builtin_amdgcn_fence(__ATOMIC_ACQUIRE, "agent");
        { pg8::Gemm g{A3, BT3, NGRP * 2048, NGRP * 256, 384, 384, 384}; EpiS3 E{gb}; GEMM_CALL(EpiS3, GroupOrder, g, S, E); }
        { const int n2 = (NGRP * NB > G && NGRP * NB - G < G) ? NGRP * NB - G : 0;
          pg8::Gemm g2{memn, (const bf16_t*)(ws + WS_WMKV0), NB * MEMT, 1024, 1024, 1024, 1024}; pg8::StaticOrder S2;
          if (G - n2 >= 32) S2.init(NB * MEMT, 1024, 1 << 20, bx >= n2 ? bx - n2 : 1 << 20); else S2.init(NB * MEMT, 1024, G, bx);
          EpiStore E2{nullptr, (bf16_t*)(ws + WS_MEMKV0), 512, 512, (bf16_t*)(ws + WS_MEMKV1), 512}; GEMM_CALL(EpiStore, pg8::StaticOrder, g2, S2, E2); }
    }
    SEAM();
    { pg8::Gemm g{gb, WGLU, NTOK, DTOK, DTOK, DTOK, DTOK}; pg8::StaticOrder S; S.init(NTOK, DTOK, G, bx); EpiGlu E{gb, tokmix}; GEMM_CALL(EpiGlu, pg8::StaticOrder, g, S, E); }
    { const int nglu = (NTOK / 256) * 3; mem_attn_phase(proj0, (const bf16_t*)(ws + WS_MEMKV0), tokmix, (char*)lds, (nglu > G && nglu - G < G) ? nglu - G : 0, 0); }
    SEAM();
    {   constexpr int l = 0;
        { pg8::Gemm g{tokmix, (const bf16_t*)(ws + (l ? WS_WOUT1 : WS_WOUT0)), NTOK, 1024, 1024, 1024, 1024}; pg8::StaticOrder S; S.init(NTOK, 1024, G, bx);
          EpiResMix E{(const void*)hb, out, hb, ss + (l ? 3 : 1) * NTOK}; GEMM_CALL(EpiResMix, pg8::StaticOrder, g, S, E); }
        SEAM();
        { pg8::Gemm g{hb, (const bf16_t*)(ws + (l ? WS_WUP1 : WS_WUP0)), NTOK, 2 * DFF, 1024, 1024, 1024}; pg8::StaticOrder S; S.init(NTOK, 2 * DFF, G, bx);
          EpiUpConv E{ss + (l ? 3 : 1) * NTOK, abuf, a.in[22] + l * 3 * DFF, a.in[23] + l * DFF, ghead, gtail};
          pg8::gemm_phase<EpiUpConv, pg8::StaticOrder, true, true, 1>(ldsl, g, S, E); }
        SEAM();
        { pg8::Gemm g{abuf, (const bf16_t*)(ws + (l ? WS_WDN1 : WS_WDN0)), NTOK, 1024, DFF, DFF, DFF}; pg8::StaticOrder S; S.init(NTOK, 1024, G, bx);
          { TIDS(); pg8::Unit uu; for (int i = 0; S.next(i, uu); ++i) convfix_panel(abuf, ghead, gtail, a.in[22] + l * 3 * DFF, uu.pm, tid); }
          asm volatile("s_waitcnt vmcnt(0)" ::: "memory"); __syncthreads();
          EpiResMix E{(const void*)hb, out, hb, ss + 2 * NTOK}; GEMM_CALL(EpiResMix, pg8::StaticOrder, g, S, E); }
        SEAM();
    }
    {
            { TIDS(); fgate_phase(hb, ss + 2 * NTOK, a.in[18], a.in[16], a.in[19], logf, (LAS float*)ldsl, tid, wid, lane); }
            { pg8::Gemm g{hb, WKVQ, NTOK, 2560, 1024, 1024, 1024}; pg8::StaticOrder S; S.init(NTOK, 2560, G, bx);
              EpiKVQ E{ss + 2 * NTOK, kvb, proj1, kmaxp}; GEMM_CALL(EpiKVQ, pg8::StaticOrder, g, S, E); }
            SEAM();
            { TIDS(); fox_attn_phase(proj1, kvb, tokmix, logf, kmaxp, kmaxp + 1024, (char*)lds, ldsl, tid, wid, lane); }
            mem_attn_phase(proj1, (const bf16_t*)(ws + WS_MEMKV1), tokmix, (char*)lds, 0, 1);
            SEAM();
    }
    {   constexpr int l = 1;
        { pg8::Gemm g{tokmix, (const bf16_t*)(ws + (l ? WS_WOUT1 : WS_WOUT0)), NTOK, 1024, 1024, 1024, 1024}; pg8::StaticOrder S; S.init(NTOK, 1024, G, bx);
          EpiResMix E{(const void*)hb, out, hb, ss + (l ? 3 : 1) * NTOK}; GEMM_CALL(EpiResMix, pg8::StaticOrder, g, S, E); }
        SEAM();
        { pg8::Gemm g{hb, (const bf16_t*)(ws + (l ? WS_WUP1 : WS_WUP0)), NTOK, 2 * DFF, 1024, 1024, 1024}; pg8::StaticOrder S; S.init(NTOK, 2 * DFF, G, bx);
          EpiUpConv E{ss + (l ? 3 : 1) * NTOK, abuf, a.in[22] + l * 3 * DFF, a.in[23] + l * DFF, ghead, gtail};
          pg8::gemm_phase<EpiUpConv, pg8::StaticOrder, true, true, 1>(ldsl, g, S, E); }
        SEAM();
        { pg8::Gemm g{abuf, (const bf16_t*)(ws + (l ? WS_WDN1 : WS_WDN0)), NTOK, 1024, DFF, DFF, DFF}; pg8::StaticOrder S; S.init(NTOK, 1024, G, bx);
          { TIDS(); pg8::Unit uu; for (int i = 0; S.next(i, uu); ++i) convfix_panel(abuf, ghead, gtail, a.in[22] + l * 3 * DFF, uu.pm, tid); }
          asm volatile("s_waitcnt vmcnt(0)" ::: "memory"); __syncthreads();
          EpiResFfn E{(const void*)hb, out, (bf16_t*)nullptr, ss + 4 * NTOK}; GEMM_CALL(EpiResFfn, pg8::StaticOrder, g, S, E); }
        SEAM();
    }
    {
        TIDS();
        const float* ss4 = ss + 4 * NTOK; f32x4 gg[4];
#pragma unroll
        for (int j = 0; j < 4; ++j) gg[j] = ((const f32x4*)a.in[25])[64 * j + lane];
#pragma unroll 1
        for (int m0 = (bx * NWAVES + wid) * 4; m0 < NTOK; m0 += G * NWAVES * 4) {
            f32x4 v[4][4]; float rs[4];
#pragma unroll
            for (int r = 0; r < 4; ++r) { rs[r] = ss4[m0 + r];
#pragma unroll
                for (int j = 0; j < 4; ++j) v[r][j] = ((const f32x4*)(out + (size_t)(m0 + r) * 1024))[64 * j + lane]; }
#pragma unroll
            for (int r = 0; r < 4; ++r) { const float s = rstd_of(rs[r]);
#pragma unroll
                for (int j = 0; j < 4; ++j) ((f32x4*)(out + (size_t)(m0 + r) * 1024))[64 * j + lane] = v[r][j] * s * gg[j]; }
        }
    }
}

extern "C" void kernel_launch(void* const* d_in, const int* in_sizes, int n_in, void* d_out, int out_size, void* d_ws, size_t ws_size, hipStream_t stream) {
    static int grid = 0;
    if (grid == 0) {
        if (n_in != 26 || out_size != NTOK * DM || ws_size < WS_END) { fprintf(stderr, "kernel_launch: unexpected shapes (n_in %d out %d ws %zu)\n", n_in, out_size, ws_size); grid = -1; return; }
        int dev = 0, cus = 0, per_cu = 0;
        hipGetDevice(&dev); hipDeviceGetAttribute(&cus, hipDeviceAttributeMultiprocessorCount, dev);
        hipFuncSetAttribute((const void*)fwd_megakernel, hipFuncAttributeMaxDynamicSharedMemorySize, LDS_BYTES);
        hipOccupancyMaxActiveBlocksPerMultiprocessor(&per_cu, (const void*)fwd_megakernel, NTHREADS, LDS_BYTES);
        if (per_cu < 1) { fprintf(stderr, "kernel_launch: occupancy query reports %d blocks/CU\n", per_cu); per_cu = 1; }
        (void)hipGetLastError();
        grid = cus * per_cu;
    }
    if (grid < 0) return;
    Args a{};
    for (int i = 0; i < 26; ++i) a.in[i] = (const float*)d_in[i];
    a.out = (float*)d_out; a.ws = (unsigned char*)d_ws;
    void* args[] = {&a};
    hipError_t e = hipLaunchCooperativeKernel((const void*)fwd_megakernel, dim3(grid), dim3(NTHREADS), args, LDS_BYTES, stream);
    if (e != hipSuccess) fprintf(stderr, "cooperative launch failed: %s (grid %d)\n", hipGetErrorString(e), grid);
}
```
